# Optimizing an MI355X kernel written in HIP

```python
import jax
import jax.numpy as jnp
from jax import lax
import numpy as np

D_MODEL = 2048
BATCH = 4
SEQ = 8192
DEPTH = 2

GRID_W = 64
CTX_LEN = 256
NORM_EPS = 1e-6
D_FF = 5632
N_BRANCH = 3
N_MOD = 9
POOL_WIDTH = 512
POOL_WINDOWS = (2, 4, 8, 16)
POOL_GROUP_DIM = POOL_WIDTH // len(POOL_WINDOWS)
RWKV_HEADS = 16
RWKV_HEAD_DIM = 64
RWKV_WIDTH = RWKV_HEADS * RWKV_HEAD_DIM
DECAY_LORA = 64
ICLR_LORA = 64
GATE_LORA = 128
RWKV_COLS = 3 * RWKV_WIDTH + 2 * DECAY_LORA + 2 * ICLR_LORA + GATE_LORA
RWKV_GN_EPS = 64e-5
GMLP_WIDTH = 512
GMLP_GROUPS = 4
GMLP_GROUP_DIM = GMLP_WIDTH // GMLP_GROUPS
GMLP_CHUNK = 128
LN_EPS = 1e-5
OFF_POOL = 0
OFF_RWKV = OFF_POOL + POOL_WIDTH
OFF_GMLP = OFF_RWKV + RWKV_COLS
OFF_GATE = OFF_GMLP + 2 * GMLP_WIDTH
IN_COLS = OFF_GATE + N_BRANCH * D_MODEL

kernel_name = 'hybrid_pool_rwkv7_gmlp_prefix_dit'


def rms_norm(x, g):
    x32 = x.astype(jnp.float32)
    y = x32 * lax.rsqrt(jnp.mean(x32 * x32, axis=-1, keepdims=True) + NORM_EPS)
    return (y * g.astype(jnp.float32)).astype(x.dtype)


def adaln(cond, ada_w, ada_b):
    m = jax.nn.silu(cond) @ ada_w + ada_b
    return m.reshape(m.shape[:-1] + (N_MOD, D_MODEL))


def swiglu(h, wg, wu, wd):
    return (jax.nn.silu(h @ wg) * (h @ wu)) @ wd


def ffn_sublayer(h, mod, base, g, wg, wu, wd):
    hn = rms_norm(h, g) * (1.0 + mod[:, :, base + 1]) + mod[:, :, base]
    return h + 0.5 * mod[:, :, base + 2] * swiglu(hn, wg, wu, wd)


def shift_seq(z):
    h = z.shape[-1] // 2
    prev = jnp.pad(z[:, :-1, :h], ((0, 0), (1, 0), (0, 0)))
    nxt = jnp.pad(z[:, 1:, h:], ((0, 0), (0, 1), (0, 0)))
    return jnp.concatenate([prev, nxt], axis=-1)


def shift_grid(z, rows):
    b, l, c = z.shape
    q = c // 4
    g = z.reshape(b, rows, GRID_W, c)
    left = jnp.pad(g[:, :, :-1, :q], ((0, 0), (0, 0), (1, 0), (0, 0)))
    right = jnp.pad(g[:, :, 1:, q:2 * q], ((0, 0), (0, 0), (0, 1), (0, 0)))
    up = jnp.pad(g[:, :-1, :, 2 * q:3 * q], ((0, 0), (1, 0), (0, 0), (0, 0)))
    down = jnp.pad(g[:, 1:, :, 3 * q:], ((0, 0), (0, 1), (0, 0), (0, 0)))
    return jnp.concatenate([left, right, up, down], axis=-1).reshape(b, l, c)


def pool_mixer(za, pool_w, pool_scale):
    b, l, c = za.shape
    x32 = za.astype(jnp.float32)
    cs = jnp.concatenate([jnp.zeros((b, 1, c), jnp.float32), jnp.cumsum(x32, axis=1)], axis=1)
    t = jnp.arange(l)
    outs = []
    for gi, w in enumerate(POOL_WINDOWS):
        sl = slice(gi * POOL_GROUP_DIM, (gi + 1) * POOL_GROUP_DIM)
        lo = jnp.clip(t - w // 2, 0, l)
        hi = jnp.clip(t - w // 2 + w, 0, l)
        csg = cs[..., sl]
        s = jnp.take(csg, hi, axis=1) - jnp.take(csg, lo, axis=1)
        cnt = (hi - lo).astype(jnp.float32)[None, :, None]
        outs.append(s / cnt - x32[..., sl])
    p = jnp.stack(outs, axis=2).astype(za.dtype)
    y = jnp.einsum('blgc,gcd->blgd', p, pool_w).reshape(b, l, c)
    return y * pool_scale


def gmlp_mixer(zu, zv, ln_g, ln_b, ws, bs):
    u = jax.nn.gelu(zu)
    v = jax.nn.gelu(zv)
    v32 = v.astype(jnp.float32)
    mu = jnp.mean(v32, axis=-1, keepdims=True)
    var = jnp.mean(jnp.square(v32 - mu), axis=-1, keepdims=True)
    v = ((v32 - mu) * lax.rsqrt(var + LN_EPS)).astype(zv.dtype) * ln_g + ln_b
    b, l, c = v.shape
    vr = v.reshape(b, l // GMLP_CHUNK, GMLP_CHUNK, GMLP_GROUPS, GMLP_GROUP_DIM)
    s = jnp.einsum('gts,bnsgc->bntgc', ws, vr) + bs.T[None, None, :, :, None]
    return u * s.reshape(b, l, c)


def rwkv_time_mix(zb, shifted, init_state, mu, w0, w_up, a0, a_up, g_up, k_k, k_a, r_k,
                  ln_g, ln_b, with_output):
    f32 = jnp.float32
    dt = zb.dtype
    b, l, _ = zb.shape
    H, N, W = RWKV_HEADS, RWKV_HEAD_DIM, RWKV_WIDTH
    zs = (zb + (shifted - zb) * mu).astype(f32)
    r = zs[..., :W]
    k = zs[..., W:2 * W]
    v = zs[..., 2 * W:3 * W]
    o = 3 * W
    wd = zs[..., o:o + 2 * DECAY_LORA].reshape(b, l, 2, DECAY_LORA)
    o += 2 * DECAY_LORA
    ad = zs[..., o:o + 2 * ICLR_LORA].reshape(b, l, 2, ICLR_LORA)
    o += 2 * ICLR_LORA
    gd = zs[..., o:o + GATE_LORA]
    w_pre = w0.astype(f32) + jnp.einsum('bldr,drc->bldc', jnp.tanh(wd), w_up.astype(f32))
    decay = jnp.exp(-jnp.exp(-jax.nn.softplus(-w_pre) - 0.5))
    a = jax.nn.sigmoid(a0.astype(f32) + jnp.einsum('bldr,drc->bldc', ad, a_up.astype(f32)))

    def heads(t):
        return t.reshape(t.shape[:-1] + (H, N))

    kk = heads(k * k_k.astype(f32))
    kk = kk / jnp.maximum(jnp.sqrt(jnp.sum(kk * kk, axis=-1, keepdims=True)), 1e-12)
    k_dir = k[:, :, None, :] * (1.0 + (a - 1.0) * k_a.astype(f32))

    def both(t):
        return jnp.stack([t, jnp.flip(t, 1)], 0).transpose(2, 0, 1, 3, 4)

    def per_dir(t):
        t = heads(t)
        return jnp.stack([t[:, :, 0], jnp.flip(t[:, :, 1], 1)], 0).transpose(2, 0, 1, 3, 4)

    rh = heads(r)
    vh = heads(v)
    xs = (per_dir(decay), per_dir(k_dir), both(vh), both(kk), per_dir(a))
    if with_output:
        xs = xs + (both(rh),)

    def step(S, inp):
        w_t, k_t, v_t, kk_t, a_t = inp[:5]
        sa = jnp.einsum('dbhvk,dbhk->dbhv', S, -kk_t)
        S = (S * w_t[..., None, :] + sa[..., None] * (kk_t * a_t)[..., None, :]
             + v_t[..., None] * k_t[..., None, :])
        if with_output:
            return S, jnp.einsum('dbhvk,dbhk->dbhv', S, inp[5])
        return S, None

    s_fin, ys = lax.scan(step, init_state, xs)
    if not with_output:
        return None, s_fin
    y = (ys[:, 0] + jnp.flip(ys[:, 1], 0)).transpose(1, 0, 2, 3)
    m = jnp.mean(y, axis=-1, keepdims=True)
    var = jnp.mean(jnp.square(y - m), axis=-1, keepdims=True)
    y = ((y - m) * lax.rsqrt(var + RWKV_GN_EPS)).reshape(b, l, W)
    y = y * ln_g.astype(f32) + ln_b.astype(f32)
    bonus = jnp.sum(rh[:, :, None] * heads(k_dir) * r_k.astype(f32), axis=(2, -1))
    y = y + (bonus[..., None] * vh).reshape(b, l, W)
    g = jax.nn.sigmoid(gd) @ g_up.astype(f32)
    return (y * g).astype(dt), s_fin


def rwkv_from_lp(zb, shifted, init_state, lp, with_output):
    return rwkv_time_mix(zb, shifted, init_state, lp['rwkv_mu'], lp['rwkv_w0'], lp['rwkv_w_up'],
                         lp['rwkv_a0'], lp['rwkv_a_up'], lp['rwkv_g_up'], lp['rwkv_k_k'],
                         lp['rwkv_k_a'], lp['rwkv_r_k'], lp['rwkv_ln_g'], lp['rwkv_ln_b'],
                         with_output)


def token_mixer(hn, rows, init_state, lp):
    z = hn @ lp['w_in']
    za = z[..., OFF_POOL:OFF_RWKV]
    zb = z[..., OFF_RWKV:OFF_GMLP]
    zu = z[..., OFF_GMLP:OFF_GMLP + GMLP_WIDTH]
    zv = z[..., OFF_GMLP + GMLP_WIDTH:OFF_GATE]
    gates = jax.nn.sigmoid(z[..., OFF_GATE:].reshape(z.shape[:-1] + (N_BRANCH, D_MODEL)))
    y_pool = pool_mixer(za, lp['pool_w'], lp['pool_scale'])
    shifted = shift_seq(zb) if rows is None else shift_grid(zb, rows)
    y_rwkv, s_fin = rwkv_from_lp(zb, shifted, init_state, lp, True)
    y_gmlp = gmlp_mixer(zu, zv, lp['gmlp_ln_g'], lp['gmlp_ln_b'], lp['gmlp_ws'], lp['gmlp_bs'])
    merged = (gates[..., 0, :] * (y_pool @ lp['proj_pool'])
              + gates[..., 1, :] * (y_rwkv @ lp['proj_rwkv'])
              + gates[..., 2, :] * (y_gmlp @ lp['proj_gmlp']))
    return merged @ lp['w_out'], s_fin


def setup_inputs(seed: int = 0) -> dict:
    key = jax.random.key(seed)
    ks = jax.random.split(key, 40)
    f32 = jnp.float32
    D, F = D_MODEL, D_FF

    def nrm(k, shape, scale):
        return jax.random.normal(k, shape, f32) * scale

    return {
        'x': nrm(ks[0], (BATCH, SEQ, D), 1.0),
        'c': nrm(ks[1], (BATCH, D), 1.0),
        'ctx': nrm(ks[2], (BATCH, CTX_LEN, D), 1.0),
        'c_ctx': nrm(ks[3], (D,), 1.0),
        'ada_w': nrm(ks[4], (DEPTH, D, N_MOD * D), 0.5 * D ** -0.5),
        'ada_b': nrm(ks[5], (DEPTH, N_MOD * D), 0.02),
        'norm_g': 1.0 + nrm(ks[6], (DEPTH, 3, D), 0.02),
        'ffn_w_gate': nrm(ks[7], (DEPTH, 2, D, F), D ** -0.5),
        'ffn_w_up': nrm(ks[8], (DEPTH, 2, D, F), D ** -0.5),
        'ffn_w_down': nrm(ks[9], (DEPTH, 2, F, D), F ** -0.5),
        'w_in': nrm(ks[10], (DEPTH, D, IN_COLS), D ** -0.5),
        'pool_w': nrm(ks[11], (DEPTH, len(POOL_WINDOWS), POOL_GROUP_DIM, POOL_GROUP_DIM), POOL_GROUP_DIM ** -0.5),
        'pool_scale': 1.0 + nrm(ks[12], (DEPTH, POOL_WIDTH), 0.02),
        'rwkv_mu': 0.5 + nrm(ks[13], (DEPTH, RWKV_COLS), 0.1),
        'rwkv_w0': nrm(ks[14], (DEPTH, 2, RWKV_WIDTH), 0.5),
        'rwkv_w_up': nrm(ks[15], (DEPTH, 2, DECAY_LORA, RWKV_WIDTH), DECAY_LORA ** -0.5),
        'rwkv_a0': nrm(ks[16], (DEPTH, 2, RWKV_WIDTH), 0.5),
        'rwkv_a_up': nrm(ks[17], (DEPTH, 2, ICLR_LORA, RWKV_WIDTH), 0.5 * ICLR_LORA ** -0.5),
        'rwkv_g_up': nrm(ks[18], (DEPTH, GATE_LORA, RWKV_WIDTH), GATE_LORA ** -0.5),
        'rwkv_k_k': 1.0 + nrm(ks[19], (DEPTH, RWKV_WIDTH), 0.1),
        'rwkv_k_a': 1.0 + nrm(ks[20], (DEPTH, RWKV_WIDTH), 0.1),
        'rwkv_r_k': nrm(ks[21], (DEPTH, RWKV_HEADS, RWKV_HEAD_DIM), 0.1),
        'rwkv_ln_g': 1.0 + nrm(ks[22], (DEPTH, RWKV_WIDTH), 0.02),
        'rwkv_ln_b': nrm(ks[23], (DEPTH, RWKV_WIDTH), 0.02),
        'gmlp_ln_g': 1.0 + nrm(ks[24], (DEPTH, GMLP_WIDTH), 0.02),
        'gmlp_ln_b': nrm(ks[25], (DEPTH, GMLP_WIDTH), 0.02),
        'gmlp_ws': nrm(ks[26], (DEPTH, GMLP_GROUPS, GMLP_CHUNK, GMLP_CHUNK), GMLP_CHUNK ** -0.5),
        'gmlp_bs': 1.0 + nrm(ks[27], (DEPTH, GMLP_GROUPS, GMLP_CHUNK), 0.02),
        'proj_pool': nrm(ks[28], (DEPTH, POOL_WIDTH, D), POOL_WIDTH ** -0.5),
        'proj_rwkv': nrm(ks[29], (DEPTH, RWKV_WIDTH, D), RWKV_WIDTH ** -0.5),
        'proj_gmlp': nrm(ks[30], (DEPTH, GMLP_WIDTH, D), GMLP_WIDTH ** -0.5),
        'w_out': nrm(ks[31], (DEPTH, D, D), D ** -0.5),
        'final_norm': 1.0 + nrm(ks[32], (D,), 0.02),
    }


def reference(x, c, ctx, c_ctx, ada_w, ada_b, norm_g, ffn_w_gate, ffn_w_up, ffn_w_down, w_in,
              pool_w, pool_scale, rwkv_mu, rwkv_w0, rwkv_w_up, rwkv_a0, rwkv_a_up, rwkv_g_up,
              rwkv_k_k, rwkv_k_a, rwkv_r_k, rwkv_ln_g, rwkv_ln_b, gmlp_ln_g, gmlp_ln_b, gmlp_ws,
              gmlp_bs, proj_pool, proj_rwkv, proj_gmlp, w_out, final_norm):
    b, l, _ = x.shape
    rows = l // GRID_W
    hc = ctx
    zero_state = jnp.zeros((2, ctx.shape[0], RWKV_HEADS, RWKV_HEAD_DIM, RWKV_HEAD_DIM), jnp.float32)
    for li in range(DEPTH):
        last = li == DEPTH - 1
        lp = {
            'w_in': w_in[li], 'pool_w': pool_w[li], 'pool_scale': pool_scale[li],
            'rwkv_mu': rwkv_mu[li], 'rwkv_w0': rwkv_w0[li], 'rwkv_w_up': rwkv_w_up[li],
            'rwkv_a0': rwkv_a0[li], 'rwkv_a_up': rwkv_a_up[li], 'rwkv_g_up': rwkv_g_up[li],
            'rwkv_k_k': rwkv_k_k[li], 'rwkv_k_a': rwkv_k_a[li], 'rwkv_r_k': rwkv_r_k[li],
            'rwkv_ln_g': rwkv_ln_g[li], 'rwkv_ln_b': rwkv_ln_b[li],
            'gmlp_ln_g': gmlp_ln_g[li], 'gmlp_ln_b': gmlp_ln_b[li],
            'gmlp_ws': gmlp_ws[li], 'gmlp_bs': gmlp_bs[li],
            'proj_pool': proj_pool[li], 'proj_rwkv': proj_rwkv[li], 'proj_gmlp': proj_gmlp[li],
            'w_out': w_out[li],
        }
        mod_c = adaln(c_ctx, ada_w[li], ada_b[li])[None, None]
        mod_x = adaln(c, ada_w[li], ada_b[li])[:, None]

        hc = ffn_sublayer(hc, mod_c, 0, norm_g[li, 0], ffn_w_gate[li, 0], ffn_w_up[li, 0], ffn_w_down[li, 0])
        hnc = rms_norm(hc, norm_g[li, 1]) * (1.0 + mod_c[:, :, 4]) + mod_c[:, :, 3]
        if last:
            zb_c = hnc @ w_in[li][:, OFF_RWKV:OFF_GMLP]
            _, s_ctx = rwkv_from_lp(zb_c, shift_seq(zb_c), zero_state, lp, False)
        else:
            m_c, s_ctx = token_mixer(hnc, None, zero_state, lp)
            hc = hc + mod_c[:, :, 5] * m_c
            hc = ffn_sublayer(hc, mod_c, 6, norm_g[li, 2], ffn_w_gate[li, 1], ffn_w_up[li, 1], ffn_w_down[li, 1])

        x = ffn_sublayer(x, mod_x, 0, norm_g[li, 0], ffn_w_gate[li, 0], ffn_w_up[li, 0], ffn_w_down[li, 0])
        hn = rms_norm(x, norm_g[li, 1]) * (1.0 + mod_x[:, :, 4]) + mod_x[:, :, 3]
        m_x, _ = token_mixer(hn, rows, s_ctx, lp)
        x = x + mod_x[:, :, 5] * m_x
        x = ffn_sublayer(x, mod_x, 6, norm_g[li, 2], ffn_w_gate[li, 1], ffn_w_up[li, 1], ffn_w_down[li, 1])
    return rms_norm(x, final_norm)
```

```cpp
#include <hip/hip_runtime.h>
#include <cstdio>
#include <cstdint>

#ifndef DBG
#define DBG 0
#ifndef NAIVE_SCAN
#define NAIVE_SCAN 0
#endif
#endif
#ifndef DBGCHK
#define DBGCHK 0
#endif
#ifndef REPMASK
#define REPMASK 0
#endif
#ifndef MK_MULTI
#define MK_MULTI 0
#endif

#define LAS __attribute__((address_space(3)))
typedef unsigned short bf16_t;
typedef short bf16x8 __attribute__((ext_vector_type(8)));
typedef short s16x4 __attribute__((ext_vector_type(4)));
typedef float f32x4 __attribute__((ext_vector_type(4)));
typedef float f32x2 __attribute__((ext_vector_type(2)));
typedef unsigned u32x4 __attribute__((ext_vector_type(4)));
typedef unsigned u32x2 __attribute__((ext_vector_type(2)));

constexpr int D = 2048, FF = 5632, NB = 4, SEQ = 8192, CTXL = 256, DEPTH = 2, NMOD = 9;
constexpr int RLAT = NB * SEQ, RCTX = NB * CTXL, NROW = RLAT + RCTX;
constexpr int NTILE = NROW / 256, NTILE_LAT = RLAT / 256;
constexpr int IN_COLS = 11136, RW_COLS = 3456, RWW = 1024;
constexpr int ZW = 5120;
constexpr int Z_RW = 512, Z_GU = 4096, Z_GV = 4608;
constexpr int GW = 6144;
constexpr int NGU = 2 * FF;
constexpr int NWIN = 11264;
constexpr int NCOND = 5;
constexpr int GRID_W = 64;
constexpr size_t MiB = 1u << 20;
constexpr size_t WS_CTL = 0;
constexpr size_t CTL_BYTES = 64 * 1024;
constexpr size_t WS_MOD = 1 * MiB;
constexpr size_t WS_BON = 2 * MiB;
constexpr size_t WS_HC = 8 * MiB;
constexpr size_t WS_W = 16 * MiB;
constexpr size_t W_GU0 = WS_W, W_D0 = W_GU0 + 44 * MiB, W_GU1 = W_D0 + 22 * MiB, W_D1 = W_GU1 + 44 * MiB, W_IN = W_D1 + 22 * MiB, W_PR = W_IN + 44 * MiB, W_OUT = W_PR + 8 * MiB;
constexpr size_t WS_HN = W_OUT + 8 * MiB;
constexpr size_t WS_XB = WS_HN;
constexpr size_t WS_YC = WS_HN + 132 * MiB;
constexpr size_t WS_A = WS_YC + 132 * MiB;
constexpr size_t WS_B = WS_A + 363 * MiB;
constexpr size_t WS_Y0 = W_GU0;
constexpr size_t WS_Y1 = WS_B + 396 * MiB;
constexpr size_t WS_END = WS_Y1 + 66 * MiB;
static_assert(WS_HN == 208 * MiB && WS_END == 1297 * MiB && W_GU1 == WS_Y0 + 66 * MiB, "ws map");

typedef __bf16 bf16x2_t __attribute__((ext_vector_type(2)));
__device__ __forceinline__ unsigned cvt_pk_bf16(float lo, float hi) { const f32x2 v = {lo, hi}; const bf16x2_t b = __builtin_convertvector(v, bf16x2_t); return __builtin_bit_cast(unsigned, b); }

__device__ __forceinline__ f32x4 zero4() { float z; asm volatile("v_mov_b32 %0, 0" : "=v"(z)); return (f32x4){z, z, z, z}; }
__device__ __forceinline__ u32x4 zero4u() { unsigned z; asm volatile("v_mov_b32 %0, 0" : "=v"(z)); return (u32x4){z, z, z, z}; }

namespace pg8 {
constexpr int BM = 256, BK = 64, HALF = 128, HTB = HALF * BK * 2, STAGE_BYTES = 8 * HTB, NXCD = 8, WGM = 8;
__host__ __device__ __forceinline__ int lds_byte(int r, int c) { const int st = (r >> 4) * 2 + (c >> 5), rr = r & 15, cc = c & 31, ob = rr * 64 + cc * 2; return st * 1024 + (ob ^ (((ob >> 9) & 1) << 5)); }
__host__ __device__ __forceinline__ void stage_rc(int b, int& R, int& C) { const int st = b / 1024, sb = b % 1024, swz = sb ^ (((sb >> 9) & 1) << 5); R = (st >> 1) * 16 + swz / 64; C = (st & 1) * 32 + (swz % 64) / 2; }
__host__ __device__ __forceinline__ int perm32(int rho) { const int n = rho >> 4, i = rho & 15; return 8 * (i >> 2) + 4 * n + (i & 3); }
struct Unit { int pm, pn, br; };
struct Gemm { const bf16_t* A; const bf16_t* Bt; int M, N, K, lda, ldb; size_t kstepA, kstepB, tstepA, tstepB; };
__host__ __device__ __forceinline__ Gemm mkgemm(const bf16_t* A, const bf16_t* Bt, int M, int N, int K, int lda, int ldb) { Gemm g; g.A = A; g.Bt = Bt; g.M = M; g.N = N; g.K = K; g.lda = lda; g.ldb = ldb; g.kstepA = 128; g.kstepB = 128; g.tstepA = (size_t)256 * lda * 2; g.tstepB = (size_t)256 * ldb * 2; return g; }
__host__ __device__ __forceinline__ Gemm mkgemm_blk(const bf16_t* A, const bf16_t* Bt, int M, int N, int K) { Gemm g; g.A = A; g.Bt = Bt; g.M = M; g.N = N; g.K = K; g.lda = 64; g.ldb = 64; g.kstepA = 32768; g.kstepB = 32768; g.tstepA = (size_t)(K / 64) * 32768; g.tstepB = g.tstepA; return g; }
struct StaticOrder {
    int nM, nN, nwg, G, c, ubeg, uend, wgm;
    __host__ __device__ void init(int M, int N, int G_, int c_) { nM = M / BM; nN = N / BM; nwg = nM * nN; G = G_; c = c_; ubeg = 0; uend = nwg; wgm = WGM; }
    __host__ __device__ void range(int b, int e) { ubeg = b; uend = e < nwg ? e : nwg; }
    __host__ __device__ bool next(int i, Unit& u) const {
        const long L = (long)ubeg + (long)i * G + c; if (L >= uend) return false;
        int wgid = (int)L; { const int q = nwg / NXCD, r = nwg % NXCD, xcd = wgid % NXCD, off = wgid / NXCD; wgid = (xcd < r ? xcd * (q + 1) : r * (q + 1) + (xcd - r) * q) + off; }
        const int nig = wgm * nN, gid = wgid / nig, fm = gid * wgm, gsz = (nM - fm) < wgm ? (nM - fm) : wgm;
        u.pm = fm + ((wgid % nig) % gsz); u.pn = (wgid % nig) / gsz; u.br = 0; return true;
    }
    __device__ __forceinline__ void operands(const Unit& u, const Gemm& g, const char*& A, const char*& B, int& nt) const {
        A = (const char*)g.A + (size_t)u.pm * g.tstepA; B = (const char*)g.Bt + (size_t)u.pn * g.tstepB; nt = g.K / BK; }
};
struct CtxSplitOrder : StaticOrder {
    __host__ __device__ bool next(int i, Unit& u) const {
        const int nlat = NTILE_LAT * nN, nctx = 4 * (nM - NTILE_LAT) * nN;
        const bool stag = (nlat % G == 0) && (G % 8 == 0) && nctx * 2 == G;
        const bool front = stag && (c & 7) < 4;
        int s_, il = i;
        if (front && i == 0) s_ = (c >> 3) * 4 + (c & 7);
        else { if (front) il = i - 1;
            const int L = il * G + c;
            if (L < nlat) { StaticOrder t = *this; t.nM = NTILE_LAT; t.nwg = nlat; t.ubeg = 0; t.uend = nlat; return t.next(il, u); }
            if (stag) return false;
            s_ = L - nlat; if (s_ >= nctx) return false; }
        const int t32 = s_ >> 2; u.pm = NTILE_LAT + t32 % (nM - NTILE_LAT); u.pn = t32 / (nM - NTILE_LAT); u.br = s_ & 3; return true;
    }
    __device__ __forceinline__ void operands(const Unit& u, const Gemm& g, const char*& A, const char*& B, int& nt) const {
        const int ks = (u.pm >= NTILE_LAT) ? (g.K >> 2) : g.K, k0 = (u.pm >= NTILE_LAT) ? u.br * ks : 0;
        A = (const char*)g.A + (size_t)u.pm * g.tstepA + (size_t)(k0 / BK) * g.kstepA; B = (const char*)g.Bt + (size_t)u.pn * g.tstepB + (size_t)(k0 / BK) * g.kstepB; nt = ks / BK; }
};
struct MergeOrder : StaticOrder {
    __host__ __device__ bool next(int i, Unit& u) const { if (!StaticOrder::next(i / 3, u)) return false; u.br = i % 3; return true; }
    __device__ __forceinline__ void operands(const Unit& u, const Gemm& g, const char*& A, const char*& B, int& nt) const {
        const int koff = u.br == 0 ? 0 : (u.br == 1 ? 512 : 1536);
        A = (const char*)g.A + (size_t)u.pm * g.tstepA + (size_t)(koff / BK) * g.kstepA; B = (const char*)g.Bt + (size_t)u.pn * g.tstepB + (size_t)(koff / BK) * g.kstepB; nt = (u.br == 1 ? 1024 : 512) / BK; }
};
struct ShiftOrder : StaticOrder { int lo, sh;
    __host__ __device__ bool next(int i, Unit& u) const { if (!StaticOrder::next(i, u)) return false; if (u.pn >= lo) u.pn += sh; return true; } };
struct W1Order { ShiftOrder R, Z; int nR;
    __host__ __device__ bool next(int i, Unit& u) const { const long L = (long)i * R.G + R.c; return L < nR ? R.next(i, u) : Z.next(i, u); }
    __device__ __forceinline__ void operands(const Unit& u, const Gemm& g, const char*& A, const char*& B, int& nt) const { R.operands(u, g, A, B, nt); } };
using ::cvt_pk_bf16;

template <class Epi, class Sched>
__device__ __forceinline__ void gemm_phase(LAS unsigned char* lds, const Gemm g, const Sched& S, const Epi& E) {
    int tid = threadIdx.x; asm volatile("" : "+v"(tid));
    const int wid = __builtin_amdgcn_readfirstlane(tid >> 6), lane = tid & 63, wr = wid >> 2, wc = wid & 3, fr = lane & 15, fq = lane >> 4;
    unsigned voffA[2], voffB[2];
#pragma unroll
    for (int i = 0; i < 2; ++i) { int R, C; stage_rc(tid * 16 + i * 8192, R, C); const int Rb = Epi::PERM ? ((R & ~31) + perm32(R & 31)) : R;
        voffA[i] = (unsigned)(R * g.lda + C) * 2u; voffB[i] = (unsigned)(Rb * g.ldb + C) * 2u; }
    const size_t kstepA = g.kstepA, kstepB = g.kstepB;
    const size_t hstepA = (size_t)HALF * g.lda * 2, hstepB = (size_t)HALF * g.ldb * 2;
    const unsigned ldsw = (unsigned)wid * 1024u;
    const int aoff = lds_byte(wr * 64 + fr, fq * 8), boff = lds_byte(wc * 32 + fr, fq * 8);
#define PG8_SA(b, h) (((b) * 2 + (h)) * HTB)
#define PG8_SB(b, h) ((4 + (b) * 2 + (h)) * HTB)
#define PG8_STAGE(bufoff, gbase, voff) do { _Pragma("unroll") for (int _i = 0; _i < 2; ++_i) \
        __builtin_amdgcn_global_load_lds((const unsigned*)((const char*)(gbase) + (voff)[_i]), (LAS unsigned*)(lds + (bufoff) + ldsw + _i * 8192), 16, 0, 0); } while (0)
#define PG8_LDA(dst, b, h) do { _Pragma("unroll") for (int m = 0; m < 4; ++m) _Pragma("unroll") for (int k = 0; k < 2; ++k) dst[m][k] = *(const LAS bf16x8*)(lds + PG8_SA(b, h) + aoff + m * 2048 + k * 1024); } while (0)
#define PG8_LDB(dst, b, h) do { _Pragma("unroll") for (int n = 0; n < 2; ++n) _Pragma("unroll") for (int k = 0; k < 2; ++k) dst[n][k] = *(const LAS bf16x8*)(lds + PG8_SB(b, h) + boff + n * 2048 + k * 1024); } while (0)
#define PG8_MMA(ai, bj, At, Bt) do { __builtin_amdgcn_s_setprio(1); _Pragma("unroll") for (int m = 0; m < 4; ++m) _Pragma("unroll") for (int n = 0; n < 2; ++n) _Pragma("unroll") for (int k = 0; k < 2; ++k) \
        acc[ai][bj][m][n] = __builtin_amdgcn_mfma_f32_16x16x32_bf16(Bt[n][k], At[m][k], acc[ai][bj][m][n], 0, 0, 0); __builtin_amdgcn_s_setprio(0); } while (0)
#define PG8_WAIT_V(n) asm volatile("s_waitcnt vmcnt(" #n ")" ::: "memory")
#define PG8_WAIT_L(n) asm volatile("s_waitcnt lgkmcnt(" #n ")" ::: "memory")
#define PG8_BAR __builtin_amdgcn_s_barrier()
#define PG8_SCHED __builtin_amdgcn_sched_barrier(0)
    Unit cur, nxt; int ui = 0;
    if (!S.next(0, cur)) return;
    f32x4 acc[2][2][4][2];
#pragma unroll
    for (int a = 0; a < 2; ++a)
#pragma unroll
        for (int b = 0; b < 2; ++b)
#pragma unroll
            for (int m = 0; m < 4; ++m)
#pragma unroll
                for (int n = 0; n < 2; ++n) acc[a][b][m][n] = (f32x4){0.f, 0.f, 0.f, 0.f};
    bf16x8 At[4][2], B0[2][2], B1[2][2];
    const char* cA; const char* cB; int nt; S.operands(cur, g, cA, cB, nt);
    PG8_STAGE(PG8_SB(0, 0), cB, voffB); PG8_STAGE(PG8_SB(0, 1), cB + hstepB, voffB); PG8_STAGE(PG8_SA(0, 0), cA, voffA); PG8_STAGE(PG8_SA(0, 1), cA + hstepA, voffA);
    if (wr == 1) PG8_BAR;
    PG8_WAIT_V(2); PG8_BAR;
    PG8_STAGE(PG8_SB(1, 0), cB + kstepB, voffB); PG8_STAGE(PG8_SA(1, 0), cA + kstepA, voffA); PG8_STAGE(PG8_SB(1, 1), cB + hstepB + kstepB, voffB);
    PG8_WAIT_V(6); PG8_BAR;
    for (;;) {
        const bool has_next = S.next(ui + 1, nxt);
        const char* nA = cA; const char* nB = cB; int nnt = nt; if (has_next) S.operands(nxt, g, nA, nB, nnt);
        for (int t = 0; t < nt; t += 2) {
            const bool last = (t == nt - 2);
            const char* a1 = cA + (size_t)(t + 1) * kstepA;
            const char* a2 = last ? nA : cA + (size_t)(t + 2) * kstepA; const char* b2 = last ? nB : cB + (size_t)(t + 2) * kstepB;
            const char* a3 = a2 + kstepA; const char* b3 = b2 + kstepB;
            PG8_LDB(B0, 0, 0); PG8_LDB(B1, 0, 1); PG8_SCHED; PG8_LDA(At, 0, 0); PG8_STAGE(PG8_SA(1, 1), a1 + hstepA, voffA);
            PG8_WAIT_V(8); PG8_WAIT_L(0); PG8_BAR; PG8_MMA(0, 0, At, B0); PG8_MMA(0, 1, At, B1); PG8_BAR; PG8_SCHED;
            PG8_LDA(At, 0, 1); PG8_STAGE(PG8_SB(0, 0), b2, voffB); PG8_STAGE(PG8_SB(0, 1), b2 + hstepB, voffB); PG8_STAGE(PG8_SA(0, 0), a2, voffA);
            PG8_WAIT_V(8); PG8_WAIT_L(0); PG8_BAR; PG8_MMA(1, 0, At, B0); PG8_MMA(1, 1, At, B1); PG8_BAR; PG8_SCHED;
            PG8_LDB(B0, 1, 0); PG8_LDB(B1, 1, 1); PG8_SCHED; PG8_LDA(At, 1, 0); PG8_STAGE(PG8_SA(0, 1), a2 + hstepA, voffA);
            PG8_WAIT_V(8); PG8_WAIT_L(0); PG8_BAR; PG8_MMA(0, 0, At, B0); PG8_MMA(0, 1, At, B1); PG8_BAR; PG8_SCHED;
            PG8_LDA(At, 1, 1); PG8_STAGE(PG8_SB(1, 0), b3, voffB); PG8_STAGE(PG8_SB(1, 1), b3 + hstepB, voffB); PG8_STAGE(PG8_SA(1, 0), a3, voffA);
            PG8_WAIT_V(8); PG8_WAIT_L(0); PG8_BAR; PG8_MMA(1, 0, At, B0); PG8_MMA(1, 1, At, B1); PG8_BAR; PG8_SCHED;
        }
        if (wr == 0) PG8_BAR;
        E(acc, cur, wr, wc, fr, fq);
        if (!has_next) break;
        if (!(Epi::KEEP_ACC && cur.br < 2)) {
#pragma unroll
        for (int a = 0; a < 2; ++a)
#pragma unroll
            for (int b = 0; b < 2; ++b)
#pragma unroll
                for (int m = 0; m < 4; ++m)
#pragma unroll
                    for (int n = 0; n < 2; ++n) acc[a][b][m][n] = (f32x4){0.f, 0.f, 0.f, 0.f}; }
        cur = nxt; cA = nA; cB = nB; nt = nnt; ++ui;
        if (wr == 1) PG8_BAR;
    }
    PG8_WAIT_V(0);
    PG8_BAR;
#undef PG8_SA
#undef PG8_SB
#undef PG8_STAGE
#undef PG8_LDA
#undef PG8_LDB
#undef PG8_MMA
#undef PG8_WAIT_V
#undef PG8_WAIT_L
#undef PG8_BAR
#undef PG8_SCHED
}
}

#define XB_TMO      128
#define XB_XCNT(j)  (256  + 64 * (j))
#define XB_XSUB(j)  (1280 + 64 * (j))
#define XB_XGEN(j)  (2304 + 64 * (j))
#define XB_TOP      3328
#define XB_TOPGEN   3392
#define XCD_BAR_WORDS 3456
#define XB_SPIN_CAP (1u << 22)
__device__ __forceinline__ unsigned xb_ld(unsigned* p)              { return __hip_atomic_load(p, __ATOMIC_RELAXED, __HIP_MEMORY_SCOPE_AGENT); }
__device__ __forceinline__ unsigned xb_add(unsigned* p, unsigned v) { return __hip_atomic_fetch_add(p, v, __ATOMIC_RELAXED, __HIP_MEMORY_SCOPE_AGENT); }
__device__ __forceinline__ unsigned xb_xcc_id() { return (unsigned)__builtin_amdgcn_s_getreg((3 << 11) | 20) & 0xFu; }
#define XB_SPIN(cond, bar) do { unsigned _sp = 0; while (cond) { __builtin_amdgcn_s_sleep(1); \
    if ((++_sp & 255u) == 0u) { if (xb_ld(&(bar)[XB_TMO])) break; if (_sp > XB_SPIN_CAP) { atomicAdd(&(bar)[XB_TMO], 1u); break; } } } } while (0)
struct XcdBarrier { unsigned* bar; unsigned x; volatile LAS unsigned* st; };
__device__ __forceinline__ XcdBarrier xcd_barrier_post(unsigned* bar, volatile LAS unsigned* st) {
    XcdBarrier b; b.bar = bar; b.x = xb_xcc_id(); b.st = st;
    if (threadIdx.x == 0) (void)xb_add(&bar[XB_XCNT(b.x)], 1u);
    return b;
}
__device__ __forceinline__ void xcd_barrier_complete(unsigned* bar, unsigned x, unsigned& nloc, unsigned& nx) {
    const unsigned G = gridDim.x * gridDim.y * gridDim.z;
    unsigned sum, cnt, mine, sp = 0u;
    for (;;) {
        sum = 0u; cnt = 0u; mine = 0u;
#pragma unroll
        for (unsigned j = 0; j < 16; ++j) { const unsigned c = xb_ld(&bar[XB_XCNT(j)]); sum += c; cnt += (c > 0u) ? 1u : 0u; mine = (j == x) ? c : mine; }
        if (sum == G) break;
        __builtin_amdgcn_s_sleep(1);
        if ((++sp & 255u) == 0u) { if (xb_ld(&bar[XB_TMO])) break; if (sp > XB_SPIN_CAP) { atomicAdd(&bar[XB_TMO], 1u); break; } }
    }
    nloc = mine > 0u ? mine : 1u; nx = cnt > 0u ? cnt : 1u;
}
__device__ __forceinline__ void xcd_barrier(const XcdBarrier& b) {
    asm volatile("s_waitcnt vmcnt(0)" ::: "memory");
    __syncthreads();
    if (threadIdx.x == 0) {
        unsigned* bar = b.bar;
        __builtin_amdgcn_s_waitcnt(0);
        unsigned nloc = b.st[0], nx = b.st[1];
        if (nloc == 0u) { xcd_barrier_complete(bar, b.x, nloc, nx); b.st[0] = nloc; b.st[1] = nx; }
        const unsigned old = xb_add(&bar[XB_XSUB(b.x)], 1u);
        const unsigned gen = old / nloc;
        if (old + 1u == (gen + 1u) * nloc) {
            __builtin_amdgcn_fence(__ATOMIC_RELEASE, "agent");
            asm volatile("s_waitcnt vmcnt(0)" ::: "memory");
            const unsigned og = xb_add(&bar[XB_TOP], 1u);
            const unsigned tg = og / nx;
            if (og + 1u == (tg + 1u) * nx) xb_add(&bar[XB_TOPGEN], 1u);
            else XB_SPIN(xb_ld(&bar[XB_TOPGEN]) == tg, bar);
            __builtin_amdgcn_fence(__ATOMIC_ACQUIRE, "agent");
            xb_add(&bar[XB_XGEN(b.x)], 1u);
            asm volatile("s_waitcnt vmcnt(0)" ::: "memory");
        } else {
            XB_SPIN(xb_ld(&bar[XB_XGEN(b.x)]) == gen, bar);
            __builtin_amdgcn_fence(__ATOMIC_ACQUIRE, "agent");
            asm volatile("s_waitcnt vmcnt(0)" ::: "memory");
        }
    }
    __syncthreads();
}

__device__ __forceinline__ unsigned pk2(float lo, float hi) { return cvt_pk_bf16(lo, hi); }
__device__ __forceinline__ unsigned f2bf(float f) { return cvt_pk_bf16(f, 0.f) & 0xffffu; }
__device__ __forceinline__ float bf_lo(unsigned w) { return __builtin_bit_cast(float, w << 16); }
__device__ __forceinline__ float bf_hi(unsigned w) { return __builtin_bit_cast(float, w & 0xffff0000u); }
typedef _Float16 h16x2_t __attribute__((ext_vector_type(2)));
__device__ __forceinline__ unsigned pk2h(float lo, float hi) { const f32x2 v = {lo, hi}; const h16x2_t h = __builtin_convertvector(v, h16x2_t); return __builtin_bit_cast(unsigned, h); }
__device__ __forceinline__ f32x2 up2h(unsigned w) { const h16x2_t h = __builtin_bit_cast(h16x2_t, w); return __builtin_convertvector(h, f32x2); }
__device__ __forceinline__ void up8h(const u32x4 w, f32x4& a, f32x4& b) { const f32x2 p0 = up2h(w.x), p1 = up2h(w.y), p2 = up2h(w.z), p3 = up2h(w.w); a = (f32x4){p0[0], p0[1], p1[0], p1[1]}; b = (f32x4){p2[0], p2[1], p3[0], p3[1]}; }
__device__ __forceinline__ float sigmoidf_(float x) { return __builtin_amdgcn_rcpf(1.0f + __expf(-x)); }
__device__ __forceinline__ float siluf_(float x) { return x * sigmoidf_(x); }
__device__ __forceinline__ float tanhf_(float x) { const float e = __expf(-2.0f * fabsf(x)); const float t = (1.0f - e) * __builtin_amdgcn_rcpf(1.0f + e); return x < 0.f ? -t : t; }
__device__ __forceinline__ float gelu_tanh(float x) { const float u = 0.7978845608f * (x + 0.044715f * x * x * x); return 0.5f * x * (1.0f + tanhf_(u)); }
__device__ __forceinline__ float wave_sum(float v) {
#pragma unroll
    for (int o = 1; o < 64; o <<= 1) v += __shfl_xor(v, o);
    return v;
}
__device__ __forceinline__ void unpack8(const u32x4 w, float (&f)[8]) { f[0] = bf_lo(w.x); f[1] = bf_hi(w.x); f[2] = bf_lo(w.y); f[3] = bf_hi(w.y); f[4] = bf_lo(w.z); f[5] = bf_hi(w.z); f[6] = bf_lo(w.w); f[7] = bf_hi(w.w); }
__device__ __forceinline__ u32x4 pack8(const float (&f)[8]) { u32x4 w; w.x = pk2(f[0], f[1]); w.y = pk2(f[2], f[3]); w.z = pk2(f[4], f[5]); w.w = pk2(f[6], f[7]); return w; }

__device__ __forceinline__ int tile_cond(int pm) { return pm < NTILE_LAT ? (pm >> 5) : 4; }
__device__ __forceinline__ int row_cond(int row) { return row < RLAT ? (row >> 13) : 4; }

__device__ __forceinline__ bf16x8 frag_row(const LAS unsigned char* M, int pitch, int row0, int ks, int lane) {
    return *(const LAS bf16x8*)(M + (row0 + (lane & 15)) * pitch + ks * 64 + (lane >> 4) * 16);
}
__device__ __forceinline__ bf16x8 frag_col(const LAS unsigned char* M, int pitch, int col0, int ks, int lane) {
    const int g = lane >> 4, q = (lane & 15) >> 2, p = lane & 3;
    const LAS unsigned char* a0 = M + (32 * ks + 8 * g + q) * pitch + (col0 + 4 * p) * 2;
    const s16x4 lo = __builtin_amdgcn_ds_read_tr16_b64_v4i16((LAS s16x4*)a0);
    const s16x4 hi = __builtin_amdgcn_ds_read_tr16_b64_v4i16((LAS s16x4*)(a0 + 4 * pitch));
    bf16x8 r; r[0] = lo[0]; r[1] = lo[1]; r[2] = lo[2]; r[3] = lo[3]; r[4] = hi[0]; r[5] = hi[1]; r[6] = hi[2]; r[7] = hi[3]; return r;
}
template <bool ACOL, bool BCOL, int KS>
__device__ __forceinline__ void mm16(f32x4& acc, const LAS unsigned char* A, int pa, int arow0, const LAS unsigned char* B, int pb, int bcol0, int lane) {
#pragma unroll
    for (int s = 0; s < KS; ++s) {
        const bf16x8 a = ACOL ? frag_col(A, pa, arow0, s, lane) : frag_row(A, pa, arow0, s, lane);
        const bf16x8 b = BCOL ? frag_col(B, pb, bcol0, s, lane) : frag_row(B, pb, bcol0, s, lane);
        acc = __builtin_amdgcn_mfma_f32_16x16x32_bf16(b, a, acc, 0, 0, 0);
    }
}

namespace pg8 {
struct EpiGU {
    static constexpr bool PERM = true, KEEP_ACC = false;
    bf16_t* H;
    __device__ __forceinline__ void operator()(const f32x4 (&acc)[2][2][4][2], const Unit& u, int wr, int wc, int fr, int fq) const {
        bf16_t* hb = H + ((size_t)(u.pm * (FF / 64) + u.pn * 2 + (wc >> 1)) * 256 + wr * 64 + fr) * 64 + (wc & 1) * 32 + 8 * fq;
#pragma unroll
        for (int ai = 0; ai < 2; ++ai)
#pragma unroll
            for (int m = 0; m < 4; ++m) {
                const f32x4 g0 = acc[ai][0][m][0], g1 = acc[ai][0][m][1], u0 = acc[ai][1][m][0], u1 = acc[ai][1][m][1];
                float o[8];
#pragma unroll
                for (int e = 0; e < 4; ++e) { o[e] = siluf_(g0[e]) * u0[e]; o[4 + e] = siluf_(g1[e]) * u1[e]; }
                u32x4 w; w.x = cvt_pk_bf16(o[0], o[1]); w.y = cvt_pk_bf16(o[2], o[3]); w.z = cvt_pk_bf16(o[4], o[5]); w.w = cvt_pk_bf16(o[6], o[7]);
                __builtin_nontemporal_store(w, (u32x4*)(hb + (ai * HALF + m * 16) * 64));
                asm volatile("" ::: "memory");
            }
    }
};
template <int ACT> struct EpiBf16 {
    static constexpr bool PERM = true, KEEP_ACC = false;
    bf16_t* O; int ldc;
    __device__ __forceinline__ void operator()(const f32x4 (&acc)[2][2][4][2], const Unit& u, int wr, int wc, int fr, int fq) const {
        const int row0 = u.pm * BM + wr * 64 + fr, col0 = u.pn * BM + wc * 32 + 8 * fq;
#pragma unroll
        for (int ai = 0; ai < 2; ++ai)
#pragma unroll
            for (int m = 0; m < 4; ++m) { bf16_t* rowp = O + (size_t)(row0 + ai * HALF + m * 16) * ldc + col0;
#pragma unroll
                for (int bj = 0; bj < 2; ++bj) { f32x4 v0 = acc[ai][bj][m][0], v1 = acc[ai][bj][m][1];
                    if (ACT == 1) {
#pragma unroll
                        for (int e = 0; e < 4; ++e) { v0[e] = sigmoidf_(v0[e]); v1[e] = sigmoidf_(v1[e]); } }
                    u32x4 w; w.x = cvt_pk_bf16(v0[0], v0[1]); w.y = cvt_pk_bf16(v0[2], v0[3]); w.z = cvt_pk_bf16(v1[0], v1[1]); w.w = cvt_pk_bf16(v1[2], v1[3]);
                    *(u32x4*)(rowp + bj * HALF) = w; }
                asm volatile("" ::: "memory"); }
    }
};
struct EpiGates {
    static constexpr bool PERM = false, KEEP_ACC = false;
    bf16_t* O; int ntn;
    __device__ __forceinline__ void operator()(const f32x4 (&acc)[2][2][4][2], const Unit& u, int wr, int wc, int fr, int fq) const {
        char* base = (char*)O + ((size_t)(u.pm * ntn + u.pn) * 8 + (wr * 4 + wc)) * 16384 + (fq * 16 + fr) * 16;
#pragma unroll
        for (int ai = 0; ai < 2; ++ai)
#pragma unroll
            for (int bj = 0; bj < 2; ++bj)
#pragma unroll
                for (int m = 0; m < 4; ++m) { const f32x4 v0 = acc[ai][bj][m][0], v1 = acc[ai][bj][m][1]; u32x4 w;
                    w.x = cvt_pk_bf16(sigmoidf_(v0[0]), sigmoidf_(v0[1])); w.y = cvt_pk_bf16(sigmoidf_(v0[2]), sigmoidf_(v0[3])); w.z = cvt_pk_bf16(sigmoidf_(v1[0]), sigmoidf_(v1[1])); w.w = cvt_pk_bf16(sigmoidf_(v1[2]), sigmoidf_(v1[3]));
                    *(u32x4*)(base + ((ai * 2 + bj) * 4 + m) * 1024) = w; }
    }
};
struct EpiResB {
    static constexpr bool PERM = true, KEEP_ACC = false;
    bf16_t* xb; float* ctxp; const float* coef  ; float cs;
    __device__ __forceinline__ void operator()(const f32x4 (&acc)[2][2][4][2], const Unit& u, int wr, int wc, int fr, int fq) const {
        int fr_ = fr; asm volatile("" : "+v"(fr_));
        const int cond = tile_cond(u.pm); const int col0 = u.pn * BM + wc * 32 + 8 * fq;
        if (u.pm >= NTILE_LAT) {
            char* pb = (char*)(ctxp + ((size_t)u.br * RCTX + (size_t)(u.pm - NTILE_LAT) * BM) * D); const unsigned oc = (unsigned)((wr * 64 + fr_) * D + col0) * 4u;
#pragma unroll
            for (int bj = 0; bj < 2; ++bj) {
                const f32x4 cf0 = *(const f32x4*)(coef + (size_t)cond * NMOD * D + col0 + bj * HALF) * cs, cf1 = *(const f32x4*)(coef + (size_t)cond * NMOD * D + col0 + bj * HALF + 4) * cs;
#pragma unroll
                for (int ai = 0; ai < 2; ++ai)
#pragma unroll
                    for (int m = 0; m < 4; ++m) { char* q = pb + (oc + (unsigned)(((ai * HALF + m * 16) * D + bj * HALF) * 4));
                        *(f32x4*)q = cf0 * acc[ai][bj][m][0]; *(f32x4*)(q + 16) = cf1 * acc[ai][bj][m][1]; }
                asm volatile("" ::: "memory"); }
            return;
        }
        typedef __attribute__((address_space(1))) char gchar; typedef __attribute__((address_space(1))) u32x4 gu32x4;
        gchar* xbb = (gchar*)(xb + (size_t)u.pm * BM * D);
        const unsigned o0 = (unsigned)((wr * 64 + fr_) * D + col0) * 2u;
#pragma unroll
        for (int bj = 0; bj < 2; ++bj) {
            u32x4 raw[2][4];
#pragma unroll
            for (int ai = 0; ai < 2; ++ai)
#pragma unroll
                for (int m = 0; m < 4; ++m) raw[ai][m] = *(const gu32x4*)(xbb + (o0 + (unsigned)(((ai * HALF + m * 16) * D + bj * HALF) * 2)));
            const f32x4 cf0 = *(const f32x4*)(coef + (size_t)cond * NMOD * D + col0 + bj * HALF) * cs, cf1 = *(const f32x4*)(coef + (size_t)cond * NMOD * D + col0 + bj * HALF + 4) * cs;
#pragma unroll
            for (int ai = 0; ai < 2; ++ai)
#pragma unroll
                for (int m = 0; m < 4; ++m) { const u32x4 x = raw[ai][m];
                    f32x4 x0, x1; up8h(x, x0, x1);
                    const f32x4 v0 = x0 + cf0 * acc[ai][bj][m][0], v1 = x1 + cf1 * acc[ai][bj][m][1];
                    u32x4 w; w.x = pk2h(v0[0], v0[1]); w.y = pk2h(v0[2], v0[3]); w.z = pk2h(v1[0], v1[1]); w.w = pk2h(v1[2], v1[3]);
                    *(gu32x4*)(xbb + (o0 + (unsigned)(((ai * HALF + m * 16) * D + bj * HALF) * 2))) = w; }
            asm volatile("" ::: "memory"); }
    }
};
struct EpiRes {
    static constexpr bool PERM = false, KEEP_ACC = false;
    const float* xi_lat; const float* xi_ctx; float* xo_lat; float* xo_ctx; const float* coef  ; float cs; int ctx_split;
    __device__ __forceinline__ void operator()(const f32x4 (&acc)[2][2][4][2], const Unit& u, int wr, int wc, int fr, int fq) const {
        const int cond = tile_cond(u.pm);
        if (ctx_split && u.pm >= NTILE_LAT) {
            typedef __attribute__((address_space(1))) float gf32;
            gf32* xo = (gf32*)(xo_ctx + (size_t)(u.pm - NTILE_LAT) * BM * D); const int col0 = u.pn * BM + wc * 32 + 4 * fq;
#pragma unroll
            for (int bj = 0; bj < 2; ++bj)
#pragma unroll
                for (int n = 0; n < 2; ++n) { const f32x4 cf = *(const f32x4*)(coef + (size_t)cond * NMOD * D + col0 + bj * HALF + n * 16) * cs;
#pragma unroll
                    for (int ai = 0; ai < 2; ++ai)
#pragma unroll
                        for (int m = 0; m < 4; ++m) { const f32x4 v = cf * acc[ai][bj][m][n]; gf32* q = xo + (size_t)(wr * 64 + fr + ai * HALF + m * 16) * D + col0 + bj * HALF + n * 16;
#pragma unroll
                            for (int e = 0; e < 4; ++e) (void)__builtin_amdgcn_global_atomic_fadd_f32(q + e, v[e]); } }
            return;
        }
        const float* xi = u.pm < NTILE_LAT ? xi_lat + (size_t)u.pm * BM * D : xi_ctx + (size_t)(u.pm - NTILE_LAT) * BM * D;
        float* xo = u.pm < NTILE_LAT ? xo_lat + (size_t)u.pm * BM * D : xo_ctx + (size_t)(u.pm - NTILE_LAT) * BM * D;
        const unsigned o0 = (unsigned)((wr * 64 + fr) * D + u.pn * BM + wc * 32 + 4 * fq) * 4u;
        const char* xib = (const char*)xi; char* xob = (char*)xo; const int col0 = u.pn * BM + wc * 32 + 4 * fq;
#pragma unroll
        for (int bj = 0; bj < 2; ++bj) {
            f32x4 bs[2][2][4], cf[2];
#pragma unroll
            for (int n = 0; n < 2; ++n) { cf[n] = *(const f32x4*)(coef + (size_t)cond * NMOD * D + col0 + bj * HALF + n * 16) * cs;
#pragma unroll
                for (int ai = 0; ai < 2; ++ai)
#pragma unroll
                    for (int m = 0; m < 4; ++m) bs[n][ai][m] = *(const f32x4*)(xib + (o0 + (unsigned)(((ai * HALF + m * 16) * D + bj * HALF + n * 16) * 4))); }
#pragma unroll
            for (int n = 0; n < 2; ++n)
#pragma unroll
                for (int ai = 0; ai < 2; ++ai)
#pragma unroll
                    for (int m = 0; m < 4; ++m) *(f32x4*)(xob + (o0 + (unsigned)(((ai * HALF + m * 16) * D + bj * HALF + n * 16) * 4))) = bs[n][ai][m] + cf[n] * acc[ai][bj][m][n];
            asm volatile("" ::: "memory"); }
    }
};
struct EpiMerge {
    static constexpr bool PERM = false, KEEP_ACC = true;
    const bf16_t* gates; bf16_t* merged;
    __device__ __forceinline__ void operator()(f32x4 (&acc)[2][2][4][2], const Unit& u, int wr, int wc, int fr, int fq) const {
        const int br = u.br; const int rl0 = wr * 64 + fr, col0 = u.pn * BM + wc * 32 + 4 * fq;
        const char* gb = (const char*)gates + ((size_t)(u.pm * 24 + br * 8 + u.pn) * 8 + (wr * 4 + wc)) * 16384 + (fq * 16 + fr) * 16;
        char* mb = (char*)(merged + (size_t)u.pm * BM * D);
#pragma unroll
        for (int ai = 0; ai < 2; ++ai) {
            u32x4 ga[2][4], gn[2][4];
#pragma unroll
            for (int bj = 0; bj < 2; ++bj)
#pragma unroll
                for (int m = 0; m < 4; ++m) { const int q = (ai * 2 + bj) * 4 + m; ga[bj][m] = *(const u32x4*)(gb + q * 1024); gn[bj][m] = br < 2 ? *(const u32x4*)(gb + 8 * 131072 + q * 1024) : (u32x4){0u, 0u, 0u, 0u}; }
#pragma unroll
            for (int bj = 0; bj < 2; ++bj)
#pragma unroll
                for (int m = 0; m < 4; ++m) { const unsigned rl = (unsigned)(rl0 + ai * HALF + m * 16);
#pragma unroll
                    for (int n = 0; n < 2; ++n) { const unsigned a0 = n ? ga[bj][m].z : ga[bj][m].x, a1 = n ? ga[bj][m].w : ga[bj][m].y, n0 = n ? gn[bj][m].z : gn[bj][m].x, n1 = n ? gn[bj][m].w : gn[bj][m].y;
                        f32x4 v = acc[ai][bj][m][n];
                        if (DBG >= 1 && DBG <= 3 && br == (DBG == 1 ? 1 : (DBG == 2 ? 0 : 2))) v = (f32x4){0.f, 0.f, 0.f, 0.f};
                        const f32x4 gcur = {fmaxf(bf_lo(a0), 1e-30f), fmaxf(bf_hi(a0), 1e-30f), fmaxf(bf_lo(a1), 1e-30f), fmaxf(bf_hi(a1), 1e-30f)};
                        if (br < 2) { const f32x4 gnx = {fmaxf(bf_lo(n0), 1e-30f), fmaxf(bf_hi(n0), 1e-30f), fmaxf(bf_lo(n1), 1e-30f), fmaxf(bf_hi(n1), 1e-30f)};
#pragma unroll
                            for (int e = 0; e < 4; ++e) v[e] *= gcur[e] * __builtin_amdgcn_rcpf(gnx[e]);
                            acc[ai][bj][m][n] = v; }
                        else { v *= gcur; u32x2 w; w.x = cvt_pk_bf16(v[0], v[1]); w.y = cvt_pk_bf16(v[2], v[3]); { const int cm = col0 + bj * HALF + n * 16; *(u32x2*)(mb + ((size_t)((cm >> 6) * 256 + rl) * 64 + (cm & 63)) * 2u) = w; } } } }
            asm volatile("" ::: "memory"); }
    }
};
}

__device__ __forceinline__ void sub_barrier(unsigned* bar, unsigned* ctr, unsigned n) {
    asm volatile("s_waitcnt vmcnt(0)" ::: "memory");
    __syncthreads();
    if (threadIdx.x == 0) {
        __builtin_amdgcn_fence(__ATOMIC_RELEASE, "agent");
        asm volatile("s_waitcnt vmcnt(0)" ::: "memory");
        (void)xb_add(ctr, 1u);
        XB_SPIN(xb_ld(ctr) < n, bar);
        __builtin_amdgcn_fence(__ATOMIC_ACQUIRE, "agent");
        asm volatile("s_waitcnt vmcnt(0)" ::: "memory");
    }
    __syncthreads();
}

struct Params { const float* in[33]; float* out; unsigned char* ws; int ph_lo, ph_hi; };
enum { I_X = 0, I_C, I_CTX, I_CCTX, I_ADAW, I_ADAB, I_NORMG, I_WG, I_WU, I_WD, I_WIN, I_POOLW, I_POOLS, I_MU, I_W0, I_WUP, I_A0, I_AUP, I_GUP, I_KK, I_KA, I_RK, I_LNG, I_LNB,
       I_GLNG, I_GLNB, I_GWS, I_GBS, I_PP, I_PR, I_PG, I_WOUT, I_FN };
constexpr int LDS_BYTES = 163840;
constexpr int LDS_BARW = LDS_BYTES - 64;

struct CvItem { const float* sp; bf16_t* dp; int N, ds; };
__device__ __forceinline__ void cv_addr(CvItem& a, const float* W, int N, bf16_t* WT, int ldd, int koff, int drow0, int k0, int n0, int lane) {
    const int kg = lane >> 3, n4 = (lane & 7) * 4;
    a.sp = W + (size_t)(k0 + 8 * kg) * N + n0 + n4; a.N = N;
    const int dr = drow0 + n4;
    if (ldd > 0) { a.dp = WT + (size_t)dr * ldd + koff + k0 + 8 * kg; a.ds = ldd; }
    else { a.dp = WT + ((size_t)((dr >> 8) * (-ldd) + (k0 >> 6)) * 256 + (dr & 255)) * 64 + 8 * kg; a.ds = 64; }
}
constexpr int CV_I_G = (D / 64) * (FF / 32), CV_I_DN = (FF / 64) * (D / 32), CV_I_IN = (D / 64) * (IN_COLS / 32), CV_I_P5 = (512 / 64) * (D / 32), CV_I_P10 = (1024 / 64) * (D / 32), CV_I_O = (D / 64) * (D / 32);
constexpr int CV_NITEMS = 2 * (2 * CV_I_G + CV_I_DN) + CV_I_IN + 2 * CV_I_P5 + CV_I_P10 + CV_I_O;
constexpr int CV_NEARLY = 2 * CV_I_G + CV_I_DN;
constexpr size_t EARLY_GU0 = 132 * MiB, EARLY_D0 = EARLY_GU0 + 44 * MiB;
constexpr size_t CTXP_OFF = 200 * MiB;
__device__ __forceinline__ void phase_conv(const Params& p, int li, LAS unsigned char* lds, const int it_lo, const int it_hi, const int wg_index, const int wg_count, bf16_t* gu0, bf16_t* dn0, const bool tail_parts) {
    int tid = threadIdx.x; asm volatile("" : "+v"(tid)); const int lane = tid & 63, wave = tid >> 6, G = gridDim.x;
    unsigned char* ws = p.ws;
    constexpr int I_G = CV_I_G, I_DN = CV_I_DN, I_IN = CV_I_IN, I_P5 = CV_I_P5, I_P10 = CV_I_P10, I_O = CV_I_O;
    const int gw = wg_index * 8 + wave, NGW = wg_count * 8;
    bf16_t* gu1 = (bf16_t*)(ws + W_GU1); bf16_t* dn1 = (bf16_t*)(ws + W_D1);
    bf16_t* win = (bf16_t*)(ws + W_IN); bf16_t* wpr = (bf16_t*)(ws + W_PR); bf16_t* wo = (bf16_t*)(ws + W_OUT);
    const float* sg0 = p.in[I_WG] + (size_t)(li * 2 + 0) * D * FF; const float* sg1 = p.in[I_WG] + (size_t)(li * 2 + 1) * D * FF;
    const float* su0 = p.in[I_WU] + (size_t)(li * 2 + 0) * D * FF; const float* su1 = p.in[I_WU] + (size_t)(li * 2 + 1) * D * FF;
    const float* sd0 = p.in[I_WD] + (size_t)(li * 2 + 0) * FF * D; const float* sd1 = p.in[I_WD] + (size_t)(li * 2 + 1) * FF * D;
#define CV_SEG(a_, CNT, SRC, NN, DST, LDD, KOFF, ROWMAP) if (r < (CNT)) { const int nblk = (NN) / 32, kb = r / nblk, n0 = 32 * (r % nblk); \
        cv_addr(a_, (SRC), (NN), (DST), (LDD), (KOFF), (ROWMAP), 64 * kb, n0, lane); } else { r -= (CNT);
#define CV_RESOLVE(a, it_) do { int r = (it_); \
        CV_SEG(a, I_G, sg0, FF, gu0, -(D / 64), 0, (n0 >> 7) * 256 + (n0 & 127)) \
        CV_SEG(a, I_G, su0, FF, gu0, -(D / 64), 0, (n0 >> 7) * 256 + 128 + (n0 & 127)) \
        CV_SEG(a, I_DN, sd0, D, dn0, -(FF / 64), 0, n0) \
        CV_SEG(a, I_G, sg1, FF, gu1, -(D / 64), 0, (n0 >> 7) * 256 + (n0 & 127)) \
        CV_SEG(a, I_G, su1, FF, gu1, -(D / 64), 0, (n0 >> 7) * 256 + 128 + (n0 & 127)) \
        CV_SEG(a, I_DN, sd1, D, dn1, -(FF / 64), 0, n0) \
        CV_SEG(a, I_IN, p.in[I_WIN] + (size_t)li * D * IN_COLS, IN_COLS, win, -(D / 64), 0, (n0 < 3968 ? n0 : n0 + 128)) \
        CV_SEG(a, I_P5, p.in[I_PP] + (size_t)li * 512 * D, D, wpr, D, 0, n0) \
        CV_SEG(a, I_P10, p.in[I_PR] + (size_t)li * 1024 * D, D, wpr, D, 512, n0) \
        CV_SEG(a, I_P5, p.in[I_PG] + (size_t)li * 512 * D, D, wpr, D, 1536, n0) \
        CV_SEG(a, I_O, p.in[I_WOUT] + (size_t)li * D * D, D, wo, -(D / 64), 0, n0) \
        } } } } } } } } } } } } while (0)
#define CV_LOAD(v, a) _Pragma("unroll") for (int i = 0; i < 8; ++i) v[i] = __builtin_nontemporal_load((const f32x4*)(a.sp + (size_t)i * a.N))
    CvItem ac, an; f32x4 vc[8], vn[8];
    ac.sp = nullptr; ac.dp = nullptr; ac.N = 0; ac.ds = 0; an = ac;
    if (it_lo + gw < it_hi) { CV_RESOLVE(ac, it_lo + gw); CV_LOAD(vc, ac); }
    for (int it = it_lo + gw; it < it_hi; it += NGW) {
        const bool more = it + NGW < it_hi;
        if (more) { CV_RESOLVE(an, it + NGW); CV_LOAD(vn, an); }
#pragma unroll
        for (int e = 0; e < 4; ++e) { u32x4 o; o.x = pk2(vc[0][e], vc[1][e]); o.y = pk2(vc[2][e], vc[3][e]); o.z = pk2(vc[4][e], vc[5][e]); o.w = pk2(vc[6][e], vc[7][e]);
            *(u32x4*)(ac.dp + (size_t)e * ac.ds) = o; }
        ac = an;
#pragma unroll
        for (int i = 0; i < 8; ++i) vc[i] = vn[i];
    }
#undef CV_LOAD
#undef CV_RESOLVE
#undef CV_SEG
    if (!tail_parts) return;
    if (li == 0) { const f32x4* src = (const f32x4*)p.in[I_CTX]; f32x4* dst = (f32x4*)(ws + WS_HC);
        for (int i = blockIdx.x * 512 + tid; i < RCTX * D / 4; i += G * 512) dst[i] = src[i]; }
    { const int n16 = 32 * 1024;
      for (int i = blockIdx.x * 512 + tid; i < n16; i += G * 512) { const int kt = i >> 10, o = i & 1023; *(u32x4*)(ws + W_IN + ((size_t)(15 * 32 + kt) * 256 + 128) * 128 + (size_t)o * 16) = zero4u(); } }
}

__device__ __forceinline__ void phase_ada(const Params& p, LAS unsigned char* lds) {
    int tid = threadIdx.x; asm volatile("" : "+v"(tid)); const int G = gridDim.x;
    LAS float* sc = (LAS float*)lds;
    LAS float* red = (LAS float*)(lds + 40960);
    float* mod = (float*)(p.ws + WS_MOD);
    constexpr int NU = DEPTH * (NMOD * D / 128);
    if ((int)blockIdx.x < NU) {
        for (int i = tid; i < NCOND * D; i += 512) { const int c = i / D, k = i % D; const float v = c < 4 ? p.in[I_C][c * D + k] : p.in[I_CCTX][k]; sc[i] = siluf_(v); }
        __syncthreads();
    }
    const int c4 = tid & 31, kg = tid >> 5;
    for (int u = blockIdx.x; u < NU; u += G) {
        const int l = u / 144, cb = u % 144, col = cb * 128 + c4 * 4;
        const float* wp = p.in[I_ADAW] + ((size_t)l * D + kg * 128) * (NMOD * D) + col;
        f32x4 acc[NCOND];
#pragma unroll
        for (int c = 0; c < NCOND; ++c) acc[c] = (f32x4){0.f, 0.f, 0.f, 0.f};
#pragma unroll 8
        for (int k = 0; k < 128; ++k) { const f32x4 w = *(const f32x4*)(wp + (size_t)k * (NMOD * D));
#pragma unroll
            for (int c = 0; c < NCOND; ++c) acc[c] += w * sc[c * D + kg * 128 + k]; }
#pragma unroll
        for (int c = 0; c < NCOND; ++c) *(LAS f32x4*)(red + (kg * NCOND + c) * 128 + c4 * 4) = acc[c];
        __syncthreads();
        for (int i = tid; i < NCOND * 128; i += 512) { const int c = i / 128, j = i % 128; float s = p.in[I_ADAB][(size_t)l * NMOD * D + cb * 128 + j];
#pragma unroll
            for (int g = 0; g < 16; ++g) s += red[(g * NCOND + c) * 128 + j];
            mod[((size_t)l * NCOND + c) * (NMOD * D) + cb * 128 + j] = s; }
        __syncthreads();
    }
}

__device__ __forceinline__ void phase_norm(const Params& p, int li, int which, const float* xlat32, const float* xctx, const int nrows, const bool wr_xb, const bool fold) {
    int tid = threadIdx.x; asm volatile("" : "+v"(tid)); const int lane = tid & 63, wave = tid >> 6, G = gridDim.x;
    bf16_t* hn = (bf16_t*)p.out; bf16_t* xb = (bf16_t*)(p.ws + WS_XB);
    const float* ng = p.in[I_NORMG] + (size_t)(li * 3 + which) * D;
    const float* modl = (const float*)(p.ws + WS_MOD) + (size_t)li * NCOND * NMOD * D;
    const int gw = blockIdx.x * 8 + wave, NW = G * 8;
    const int rbeg = (int)((long)gw * nrows / NW), rend = (int)((long)(gw + 1) * nrows / NW);
    int ccur = -1; f32x4 gm[8], sh[8]; u32x4 rc[8], rn[8]; bool kc = false, kn = false;
#define NORM_LOAD(dst, kind, row_) do { const int r_ = (row_); kind = (r_ < RLAT) && (xlat32 == nullptr); \
        if (kind) { const bf16_t* xr_ = xb + (size_t)r_ * D; _Pragma("unroll") for (int j = 0; j < 4; ++j) dst[j] = __builtin_nontemporal_load((const u32x4*)(xr_ + (lane + 64 * j) * 8)); } \
        else { const float* xr_ = r_ < RLAT ? xlat32 + (size_t)r_ * D : xctx + (size_t)(r_ - RLAT) * D; \
            _Pragma("unroll") for (int j = 0; j < 8; ++j) dst[j] = __builtin_nontemporal_load((const u32x4*)(xr_ + (lane + 64 * (j >> 1)) * 8 + 4 * (j & 1))); } } while (0)
    if (fold) {
        float* hcw = (float*)(p.ws + WS_HC); const float* cp = (const float*)((const unsigned char*)p.out + CTXP_OFF);
        for (int row = rbeg > RLAT ? rbeg : RLAT; row < rend; ++row) { float* hr = hcw + (size_t)(row - RLAT) * D;
#pragma unroll
            for (int j = 0; j < 8; ++j) { const int col = (lane + 64 * (j >> 1)) * 8 + 4 * (j & 1); f32x4 a = *(const f32x4*)(hr + col);
#pragma unroll
                for (int q = 0; q < 4; ++q) a += *(const f32x4*)(cp + ((size_t)q * RCTX + (row - RLAT)) * D + col);
                *(f32x4*)(hr + col) = a; } }
        asm volatile("s_waitcnt vmcnt(0)" ::: "memory");
    }
    if (rbeg < rend) NORM_LOAD(rc, kc, rbeg);
    for (int row = rbeg; row < rend; ++row) {
        if (row + 1 < rend) NORM_LOAD(rn, kn, row + 1);
        const int cond = row_cond(row);
        if (cond != ccur) { ccur = cond; const float* msh = modl + ((size_t)cond * NMOD + 3 * which) * D; const float* msc = msh + D;
#pragma unroll
            for (int j = 0; j < 8; ++j) { const int col = (lane + 64 * (j >> 1)) * 8 + 4 * (j & 1); gm[j] = *(const f32x4*)(ng + col) * (*(const f32x4*)(msc + col) + 1.0f); sh[j] = *(const f32x4*)(msh + col); } }
        f32x4 v[8];
        if (kc) {
#pragma unroll
            for (int j = 0; j < 4; ++j) up8h(rc[j], v[2 * j], v[2 * j + 1]); }
        else {
#pragma unroll
            for (int j = 0; j < 8; ++j) v[j] = __builtin_bit_cast(f32x4, rc[j]); }
        float ss = 0.f;
#pragma unroll
        for (int j = 0; j < 8; ++j) ss += (v[j][0] * v[j][0] + v[j][1] * v[j][1]) + (v[j][2] * v[j][2] + v[j][3] * v[j][3]);
        const float rstd = 1.0f / sqrtf(wave_sum(ss) * (1.0f / D) + 1e-6f);
        if (wr_xb && row < RLAT) {
#pragma unroll
            for (int j = 0; j < 4; ++j) { u32x4 w; w.x = pk2h(v[2 * j][0], v[2 * j][1]); w.y = pk2h(v[2 * j][2], v[2 * j][3]); w.z = pk2h(v[2 * j + 1][0], v[2 * j + 1][1]); w.w = pk2h(v[2 * j + 1][2], v[2 * j + 1][3]);
                *(u32x4*)(xb + (size_t)row * D + (lane + 64 * j) * 8) = w; } }
#pragma unroll
        for (int j = 0; j < 4; ++j) { const int col = (lane + 64 * j) * 8;
            const f32x4 y0 = (v[2 * j] * rstd) * gm[2 * j] + sh[2 * j], y1 = (v[2 * j + 1] * rstd) * gm[2 * j + 1] + sh[2 * j + 1];
            u32x4 w; w.x = pk2(y0[0], y0[1]); w.y = pk2(y0[2], y0[3]); w.z = pk2(y1[0], y1[1]); w.w = pk2(y1[2], y1[3]);
            *(u32x4*)(hn + ((size_t)((row >> 8) * (D / 64) + (col >> 6)) * 256 + (row & 255)) * 64 + (col & 63)) = w; }
#pragma unroll
        for (int j = 0; j < 8; ++j) rc[j] = rn[j];
        kc = kn;
    }
#undef NORM_LOAD
}
__device__ __forceinline__ void phase_final(const Params& p) {
    int tid = threadIdx.x; asm volatile("" : "+v"(tid)); const int lane = tid & 63, wave = tid >> 6, G = gridDim.x;
    const float* fg = p.in[I_FN]; const bf16_t* xb = (const bf16_t*)(p.ws + WS_XB);
    for (int row0 = (blockIdx.x * 8 + wave) * 2; row0 < RLAT; row0 += G * 16) {
        u32x4 rw[2][4];
#pragma unroll
        for (int r = 0; r < 2; ++r)
#pragma unroll
            for (int j = 0; j < 4; ++j) rw[r][j] = __builtin_nontemporal_load((const u32x4*)(xb + (size_t)(row0 + r) * D + (lane + 64 * j) * 8));
#pragma unroll
        for (int r = 0; r < 2; ++r) { const int row = row0 + r; float* xr = p.out + (size_t)row * D;
            f32x4 v[8]; float ss = 0.f;
#pragma unroll
            for (int j = 0; j < 4; ++j) up8h(rw[r][j], v[2 * j], v[2 * j + 1]);
#pragma unroll
            for (int j = 0; j < 8; ++j) ss += (v[j][0] * v[j][0] + v[j][1] * v[j][1]) + (v[j][2] * v[j][2] + v[j][3] * v[j][3]);
            float rstd = 1.0f / sqrtf(wave_sum(ss) * (1.0f / D) + 1e-6f);
            if (DBGCHK) { const unsigned* dbg = (const unsigned*)(p.ws + 32768); float sc = 0.f; sc = dbg[4] ? 0.2f * (1.0f + log2f((float)dbg[4] + 1.0f)) : 0.f; rstd *= (1.0f + sc); }
            if (DBG == 7) { const int pos = row & (SEQ - 1); if (pos < 64 || pos >= SEQ - 64) rstd = 0.f; }
#pragma unroll
            for (int j = 0; j < 8; ++j) { const int col = (lane + 64 * (j >> 1)) * 8 + 4 * (j & 1); *(f32x4*)(xr + col) = v[j] * rstd * *(const f32x4*)(fg + col); } }
    }
}

__device__ __forceinline__ size_t ycb(int row, int col) { return ((size_t)((row >> 8) * (D / 64) + (col >> 6)) * 256 + (row & 255)) * 64 + (col & 63); }

constexpr int P272 = 272;
__device__ __forceinline__ void load_w128(const float* src, LAS unsigned char* dst, int tid) {
    const int r = tid >> 2, c0 = (tid & 3) * 32;
#pragma unroll
    for (int i = 0; i < 4; ++i) { const f32x4 a = *(const f32x4*)(src + r * 128 + c0 + 8 * i), b = *(const f32x4*)(src + r * 128 + c0 + 8 * i + 4);
        u32x4 w; w.x = pk2(a[0], a[1]); w.y = pk2(a[2], a[3]); w.z = pk2(b[0], b[1]); w.w = pk2(b[2], b[3]);
        *(LAS u32x4*)(dst + r * P272 + (c0 + 8 * i) * 2) = w; }
}
__device__ __forceinline__ void pool_unit(const Params& p, int li, int blk, int g, LAS unsigned char* lds, const bool load_w) {
    int tid = threadIdx.x; asm volatile("" : "+v"(tid)); const int lane = tid & 63, wave = tid >> 6;
    LAS float* ZA = (LAS float*)lds;
    LAS unsigned char* PB = lds + 144 * 128 * 4;
    LAS unsigned char* PW = PB + 128 * P272;
    const bf16_t* zs = (const bf16_t*)(p.ws + WS_A);
    bf16_t* yc = (bf16_t*)(p.ws + WS_YC);
    const int row0 = blk * 128;
    const int L = row0 < RLAT ? SEQ : CTXL, pos0 = row0 < RLAT ? (row0 & (SEQ - 1)) : ((row0 - RLAT) & (CTXL - 1));
    if (load_w) load_w128(p.in[I_POOLW] + (size_t)(li * 4 + g) * 128 * 128, PW, tid);
    { const int c8 = tid & 15, rr = tid >> 4;
      u32x4 w5[5];
#pragma unroll
      for (int k = 0; k < 5; ++k) { const int tl = rr + 32 * k, pos = pos0 + tl - 8; const bool ok = tl < 144 && pos >= 0 && pos < L;
          w5[k] = *(const u32x4*)(zs + (size_t)(ok ? row0 + tl - 8 : row0) * ZW + g * 128 + c8 * 8); }
#pragma unroll
      for (int k = 0; k < 5; ++k) { const int tl = rr + 32 * k, pos = pos0 + tl - 8; const bool ok = pos >= 0 && pos < L; float f[8]; unpack8(w5[k], f);
          if (!ok) {
#pragma unroll
              for (int e = 0; e < 8; ++e) f[e] = 0.f; }
          if (tl < 144) { *(LAS f32x4*)(ZA + tl * 128 + c8 * 8) = (f32x4){f[0], f[1], f[2], f[3]}; *(LAS f32x4*)(ZA + tl * 128 + c8 * 8 + 4) = (f32x4){f[4], f[5], f[6], f[7]}; } } }
    __syncthreads();
    { const int c = tid & 127, ts = tid >> 7, half = 1 << g; const int t0 = ts * 32;
      float s = 0.f;
      for (int u = t0 - half; u < t0 + half; ++u) s += ZA[(u + 8) * 128 + c];
      for (int t = t0; t < t0 + 32; ++t) { const int pos = pos0 + t; const int lo = pos - half < 0 ? 0 : pos - half, hi = pos + half > L ? L : pos + half;
          const float pv = s / (float)(hi - lo) - ZA[(t + 8) * 128 + c];
          *(LAS unsigned short*)(PB + t * P272 + c * 2) = (unsigned short)f2bf(pv);
          s += ZA[(t + half + 8) * 128 + c] - ZA[(t - half + 8) * 128 + c]; } }
    __syncthreads();
    { f32x4 acc[8];
#pragma unroll
      for (int j = 0; j < 8; ++j) { acc[j] = zero4(); mm16<false, true, 4>(acc[j], PB, P272, 16 * wave, PW, P272, 16 * j, lane); }
      const int fr = lane & 15, fq = lane >> 4; const float* psc = p.in[I_POOLS] + (size_t)li * 512 + g * 128;
#pragma unroll
      for (int j = 0; j < 8; ++j) { const int d = 16 * j + 4 * fq; const f32x4 sc = *(const f32x4*)(psc + d); const f32x4 y = acc[j] * sc;
          u32x2 w; w.x = pk2(y[0], y[1]); w.y = pk2(y[2], y[3]);
          *(u32x2*)(yc + ycb(row0 + 16 * wave + fr, g * 128 + d)) = w; } }
    __syncthreads();
}

__device__ __forceinline__ void gmlp_unit(const Params& p, int li, int blk, int g, LAS unsigned char* lds, const bool load_w) {
    int tid = threadIdx.x; asm volatile("" : "+v"(tid)); const int lane = tid & 63, wave = tid >> 6;
    LAS unsigned char* WS_ = lds;
    LAS unsigned char* VN = lds + 128 * P272;
    LAS float* ST = (LAS float*)(lds + 2 * 128 * P272);
    const bf16_t* zs = (const bf16_t*)(p.ws + WS_A);
    bf16_t* yc = (bf16_t*)(p.ws + WS_YC);
    const int row0 = blk * 128;
    if (load_w) load_w128(p.in[I_GWS] + (size_t)(li * 4 + g) * 128 * 128, WS_, tid);
    u32x4 raw[16];
#pragma unroll
    for (int i = 0; i < 16; ++i) raw[i] = *(const u32x4*)(zs + (size_t)(row0 + wave * 16 + i) * ZW + Z_GV + lane * 8);
#pragma unroll
    for (int i = 0; i < 16; ++i) { const int t = wave * 16 + i; float f[8]; unpack8(raw[i], f);
        float s = 0.f;
#pragma unroll
        for (int e = 0; e < 8; ++e) { f[e] = gelu_tanh(f[e]); s += f[e]; }
        const float mean = wave_sum(s) * (1.0f / 512.0f); float q = 0.f;
#pragma unroll
        for (int e = 0; e < 8; ++e) { const float d = f[e] - mean; q += d * d; }
        const float rstd = 1.0f / sqrtf(wave_sum(q) * (1.0f / 512.0f) + 1e-5f);
        if (lane == 0) { ST[2 * t] = mean; ST[2 * t + 1] = rstd; } }
    __syncthreads();
    { const int s = tid >> 2, c0 = (tid & 3) * 32; const float mean = ST[2 * s], rstd = ST[2 * s + 1];
      const float* lg = p.in[I_GLNG] + (size_t)li * 512 + g * 128 + c0; const float* lb = p.in[I_GLNB] + (size_t)li * 512 + g * 128 + c0;
#pragma unroll
      for (int i = 0; i < 4; ++i) { float f[8]; unpack8(*(const u32x4*)(zs + (size_t)(row0 + s) * ZW + Z_GV + g * 128 + c0 + 8 * i), f);
          const f32x4 g0 = *(const f32x4*)(lg + 8 * i), g1 = *(const f32x4*)(lg + 8 * i + 4), b0 = *(const f32x4*)(lb + 8 * i), b1 = *(const f32x4*)(lb + 8 * i + 4);
#pragma unroll
          for (int e = 0; e < 4; ++e) { f[e] = (gelu_tanh(f[e]) - mean) * rstd * g0[e] + b0[e]; f[4 + e] = (gelu_tanh(f[4 + e]) - mean) * rstd * g1[e] + b1[e]; }
          *(LAS u32x4*)(VN + s * P272 + (c0 + 8 * i) * 2) = pack8(f); } }
    __syncthreads();
    { f32x4 acc[8];
#pragma unroll
      for (int j = 0; j < 8; ++j) { acc[j] = zero4(); mm16<false, true, 4>(acc[j], WS_, P272, 16 * wave, VN, P272, 16 * j, lane); }
      const int fr = lane & 15, fq = lane >> 4, t = 16 * wave + fr; const float bs = p.in[I_GBS][(size_t)(li * 4 + g) * 128 + t];
#pragma unroll
      for (int j = 0; j < 8; ++j) { const int c = g * 128 + 16 * j + 4 * fq;
          const u32x2 uw = *(const u32x2*)(zs + (size_t)(row0 + t) * ZW + Z_GU + c);
          const float u0 = gelu_tanh(bf_lo(uw.x)), u1 = gelu_tanh(bf_hi(uw.x)), u2 = gelu_tanh(bf_lo(uw.y)), u3 = gelu_tanh(bf_hi(uw.y));
          u32x2 w; w.x = pk2(u0 * (acc[j][0] + bs), u1 * (acc[j][1] + bs)); w.y = pk2(u2 * (acc[j][2] + bs), u3 * (acc[j][3] + bs));
          *(u32x2*)(yc + ycb(row0 + t, 1536 + c)) = w; } }
    __syncthreads();
}

constexpr int P144 = 144;
constexpr int SLOT = 64 * P144;
#define SL(i) ((i) * SLOT)
enum { S_WUP = 0, S_AUP, S_S0B, S_TW  , S_AD  , S_KT  , S_RT  , S_BH, S_KH, S_V, S_LA, S_GA, S_AAK  , S_ARB, S_ARK, S_V2, S_ADP, S_NSLOT };
constexpr int SC_WPRE = SL(S_LA), SC_APRE = SL(S_KT);
constexpr int SC_SEG = SL(S_NSLOT), SC_GC = SC_SEG + 2048, SC_PAR = SC_GC + 256;
enum { PR_W0 = 0, PR_A0, PR_KK, PR_KA, PR_RK, PR_MUR, PR_MUK, PR_MUV, PR_MUW, PR_MUA };
static_assert(SC_PAR + 10 * 256 <= LDS_BARW, "scan LDS map");

__device__ __forceinline__ int shift_nbr(bool isctx, int ac, int pos, int row, bool& valid) {
    if (isctx) { if (ac < RW_COLS / 2) { valid = pos > 0; return row - 1; } valid = pos < CTXL - 1; return row + 1; }
    const int q = ac / (RW_COLS / 4);
    if (q == 0) { valid = (pos & (GRID_W - 1)) > 0; return row - 1; }
    if (q == 1) { valid = (pos & (GRID_W - 1)) < GRID_W - 1; return row + 1; }
    if (q == 2) { valid = pos >= GRID_W; return row - GRID_W; }
    valid = pos < SEQ - GRID_W; return row + GRID_W;
}
__device__ __forceinline__ void load_lerp8(const bf16_t* zs, bool isctx, int ac, int pos, int row, const float (&mu)[8], float (&out)[8]) {
    bool valid; const int nr = shift_nbr(isctx, ac, pos, row, valid);
    float a[8], b[8];
    unpack8(*(const u32x4*)(zs + (size_t)row * ZW + Z_RW + ac), a);
    if (valid) unpack8(*(const u32x4*)(zs + (size_t)nr * ZW + Z_RW + ac), b);
    else {
#pragma unroll
        for (int e = 0; e < 8; ++e) b[e] = 0.f; }
#pragma unroll
    for (int e = 0; e < 8; ++e) out[e] = a[e] + (b[e] - a[e]) * mu[e];
}
__device__ __forceinline__ void load_raw8(const bf16_t* zs, bool isctx, int ac, int pos, int row, u32x4& a, u32x4& b, unsigned& vmask, int bit) {
    bool valid; const int nr = shift_nbr(isctx, ac, pos, row, valid);
    const bf16_t* p0 = zs + (size_t)row * ZW + Z_RW + ac; const bf16_t* p1 = zs + (size_t)(valid ? nr : row) * ZW + Z_RW + ac;
    a = *(const u32x4*)p0; b = *(const u32x4*)p1;
    vmask = valid ? (vmask | (1u << bit)) : (vmask & ~(1u << bit));
}
__device__ __forceinline__ void lerp_raw8(const u32x4 a_, const u32x4 bb_, const bool valid, const float (&mu)[8], float (&out)[8]) {
    const unsigned m_ = valid ? 0xffffffffu : 0u; const u32x4 b_ = {bb_.x & m_, bb_.y & m_, bb_.z & m_, bb_.w & m_};
    float a[8], b[8]; unpack8(a_, a); unpack8(b_, b);
#pragma unroll
    for (int e = 0; e < 8; ++e) out[e] = a[e] + (b[e] - a[e]) * mu[e];
}
__device__ __forceinline__ void lds_ld8(const LAS float* p, float (&o)[8]) { const f32x4 a = *(const LAS f32x4*)p, b = *(const LAS f32x4*)(p + 4); o[0] = a[0]; o[1] = a[1]; o[2] = a[2]; o[3] = a[3]; o[4] = b[0]; o[5] = b[1]; o[6] = b[2]; o[7] = b[3]; }
__device__ __forceinline__ void st_bf4(LAS unsigned char* M, int row, int col, const f32x4 v) { u32x2 w; w.x = pk2(v[0], v[1]); w.y = pk2(v[2], v[3]); *(LAS u32x2*)(M + row * P144 + col * 2) = w; }

__device__ __forceinline__ void phase_scan(const Params& p, int li, LAS unsigned char* lds, const int q) {
    int tid = threadIdx.x; asm volatile("" : "+v"(tid)); const int lane = tid & 63, wave = tid >> 6;
    const int dir = q & 1, h = (q >> 1) & 15, b = q >> 5;
    const bf16_t* zs = (const bf16_t*)(p.ws + WS_A);
    bf16_t* yout = (bf16_t*)(p.ws + (dir ? WS_Y1 : WS_Y0));
    float* bon = (float*)(p.ws + WS_BON) + (size_t)dir * NROW * 16;
    LAS float* PAR = (LAS float*)(lds + SC_PAR); LAS float* GC = (LAS float*)(lds + SC_GC); LAS float* SEG = (LAS float*)(lds + SC_SEG);
    LAS float* WPRE = (LAS float*)(lds + SC_WPRE); LAS float* APRE = (LAS float*)(lds + SC_APRE);
    if (tid < 64) { const int k = tid, c = h * 64 + k;
        PAR[PR_W0 * 64 + k] = p.in[I_W0][(size_t)(li * 2 + dir) * RWW + c]; PAR[PR_A0 * 64 + k] = p.in[I_A0][(size_t)(li * 2 + dir) * RWW + c];
        PAR[PR_KK * 64 + k] = p.in[I_KK][(size_t)li * RWW + c]; PAR[PR_KA * 64 + k] = p.in[I_KA][(size_t)li * RWW + c]; PAR[PR_RK * 64 + k] = p.in[I_RK][(size_t)li * RWW + c];
        const float* mu = p.in[I_MU] + (size_t)li * RW_COLS;
        PAR[PR_MUR * 64 + k] = mu[c]; PAR[PR_MUK * 64 + k] = mu[1024 + c]; PAR[PR_MUV * 64 + k] = mu[2048 + c];
        PAR[PR_MUW * 64 + k] = mu[3072 + dir * 64 + k]; PAR[PR_MUA * 64 + k] = mu[3072 + 128 + dir * 64 + k]; }
    { const int j = tid >> 3, cg = tid & 7;
      const float* wu = p.in[I_WUP] + ((size_t)(li * 2 + dir) * 64 + j) * RWW + h * 64 + cg * 8; const float* au = p.in[I_AUP] + ((size_t)(li * 2 + dir) * 64 + j) * RWW + h * 64 + cg * 8;
      float f[8];
#pragma unroll
      for (int e = 0; e < 8; ++e) f[e] = wu[e];
      *(LAS u32x4*)(lds + SL(S_WUP) + j * P144 + cg * 16) = pack8(f);
#pragma unroll
      for (int e = 0; e < 8; ++e) f[e] = au[e];
      *(LAS u32x4*)(lds + SL(S_AUP) + j * P144 + cg * 16) = pack8(f);
      *(LAS u32x4*)(lds + SL(S_S0B) + j * P144 + cg * 16) = zero4u(); }
    __syncthreads();
    const int tr = wave >> 1, tc0 = (wave & 1) * 2, fr = lane & 15, fq = lane >> 4;
    const int mrow = 16 * tr + fr;
    f32x4 accS[2] = {(f32x4){0.f, 0.f, 0.f, 0.f}, (f32x4){0.f, 0.f, 0.f, 0.f}};
    const int s_ = tid >> 3, cg = tid & 7;
    u32x4 pa[5], pb[5]; unsigned vmask = 0u;
#define SCAN_GEOM(jj) const bool isctx = (jj) < 4; const int jl = isctx ? (jj) : (jj) - 4; const int L = isctx ? CTXL : SEQ; const int rowbase = isctx ? RLAT + b * CTXL : b * SEQ; \
        const int pos = dir ? L - 1 - (64 * jl + s_) : 64 * jl + s_; const int row = rowbase + pos;
#define SCAN_ISSUE() do { load_raw8(zs, isctx, h * 64 + cg * 8, pos, row, pa[0], pb[0], vmask, 0); load_raw8(zs, isctx, 1024 + h * 64 + cg * 8, pos, row, pa[1], pb[1], vmask, 1); load_raw8(zs, isctx, 2048 + h * 64 + cg * 8, pos, row, pa[2], pb[2], vmask, 2); \
        load_raw8(zs, isctx, 3072 + dir * 64 + cg * 8, pos, row, pa[3], pb[3], vmask, 3); load_raw8(zs, isctx, 3072 + 128 + dir * 64 + cg * 8, pos, row, pa[4], pb[4], vmask, 4); } while (0)
#define SCAN_STEP1(vdst) do { float mu[8], t8[8]; \
          lds_ld8(PAR + PR_MUR * 64 + cg * 8, mu); lerp_raw8(pa[0], pb[0], (vmask >> 0) & 1, mu, r8); \
          lds_ld8(PAR + PR_MUK * 64 + cg * 8, mu); lerp_raw8(pa[1], pb[1], (vmask >> 1) & 1, mu, k8); \
          lds_ld8(PAR + PR_MUV * 64 + cg * 8, mu); lerp_raw8(pa[2], pb[2], (vmask >> 2) & 1, mu, t8); \
          *(LAS u32x4*)(lds + (vdst) + s_ * P144 + cg * 16) = pack8(t8); \
          lds_ld8(PAR + PR_MUW * 64 + cg * 8, mu); lerp_raw8(pa[3], pb[3], (vmask >> 3) & 1, mu, t8); \
          _Pragma("unroll") for (int e = 0; e < 8; ++e) t8[e] = tanhf_(t8[e]); \
          *(LAS u32x4*)(lds + SL(S_AAK) + s_ * P144 + cg * 16) = pack8(t8); \
          lds_ld8(PAR + PR_MUA * 64 + cg * 8, mu); lerp_raw8(pa[4], pb[4], (vmask >> 4) & 1, mu, t8); \
          *(LAS u32x4*)(lds + SL(S_ADP) + s_ * P144 + cg * 16) = pack8(t8); } while (0)
#define SCAN_LORA() do { _Pragma("unroll") for (int jn = 0; jn < 2; ++jn) { const int c0 = 16 * (tc0 + jn); \
            f32x4 a1 = {0.f, 0.f, 0.f, 0.f}, a2 = {0.f, 0.f, 0.f, 0.f}; \
            mm16<false, true, 2>(a1, lds + SL(S_AAK), P144, 16 * tr, lds + SL(S_WUP), P144, c0, lane); \
            mm16<false, true, 2>(a2, lds + SL(S_ADP), P144, 16 * tr, lds + SL(S_AUP), P144, c0, lane); \
            *(LAS f32x4*)(WPRE + mrow * 64 + c0 + 4 * fq) = a1; *(LAS f32x4*)(APRE + mrow * 64 + c0 + 4 * fq) = a2; } } while (0)
    float r8[8], k8[8];
    { SCAN_GEOM(0) SCAN_ISSUE(); }
    SCAN_STEP1(SL(S_V));
    __syncthreads();
    SCAN_LORA();
    __syncthreads();
    for (int j = 0; j < 132; ++j) {
        SCAN_GEOM(j)
        const int vsl = (j & 1) ? SL(S_V2) : SL(S_V), vnx = (j & 1) ? SL(S_V) : SL(S_V2);
        float kkn[8], kd[8], bb[8], lw[8];
        if (DBG == 6) { accS[0] = (f32x4){0.f, 0.f, 0.f, 0.f}; accS[1] = accS[0]; *(LAS u32x4*)(lds + SL(S_S0B) + s_ * P144 + cg * 16) = (u32x4){0u, 0u, 0u, 0u}; }
        { float wp[8], ap[8], pw0[8], pa0[8], pkk[8], pka[8], prk[8];
          lds_ld8(WPRE + s_ * 64 + cg * 8, wp); lds_ld8(APRE + s_ * 64 + cg * 8, ap);
          lds_ld8(PAR + PR_W0 * 64 + cg * 8, pw0); lds_ld8(PAR + PR_A0 * 64 + cg * 8, pa0); lds_ld8(PAR + PR_KK * 64 + cg * 8, pkk); lds_ld8(PAR + PR_KA * 64 + cg * 8, pka); lds_ld8(PAR + PR_RK * 64 + cg * 8, prk);
          float n2 = 0.f, bsum = 0.f;
#pragma unroll
          for (int e = 0; e < 8; ++e) { lw[e] = -0.60653066f * sigmoidf_(wp[e] + pw0[e]); const float a = sigmoidf_(ap[e] + pa0[e]);
              kkn[e] = k8[e] * pkk[e]; n2 += kkn[e] * kkn[e]; kd[e] = k8[e] * (1.0f + (a - 1.0f) * pka[e]); bb[e] = a; bsum += r8[e] * kd[e] * prk[e]; }
          n2 += __shfl_xor(n2, 1); n2 += __shfl_xor(n2, 2); n2 += __shfl_xor(n2, 4);
          bsum += __shfl_xor(bsum, 1); bsum += __shfl_xor(bsum, 2); bsum += __shfl_xor(bsum, 4);
          const float inv = 1.0f / fmaxf(sqrtf(n2), 1e-12f);
#pragma unroll
          for (int e = 0; e < 8; ++e) { kkn[e] *= inv; bb[e] *= kkn[e]; }
          bon[(size_t)row * 16 + h] = bsum;
          *(LAS f32x4*)(WPRE + s_ * 64 + cg * 8) = (f32x4){lw[0], lw[1], lw[2], lw[3]}; *(LAS f32x4*)(WPRE + s_ * 64 + cg * 8 + 4) = (f32x4){lw[4], lw[5], lw[6], lw[7]}; }
        __syncthreads();
        { const int k = tid & 63, sg = tid >> 6; float pre[8]; float run = 0.f;
#pragma unroll
          for (int i = 0; i < 8; ++i) { run += WPRE[(8 * sg + i) * 64 + k]; pre[i] = run; }
          SEG[sg * 64 + k] = run;
          __syncthreads();
          float off = 0.f;
#pragma unroll
          for (int s2 = 0; s2 < 8; ++s2) off += (s2 < sg) ? SEG[s2 * 64 + k] : 0.f;
#pragma unroll
          for (int i = 0; i < 8; ++i) WPRE[(8 * sg + i) * 64 + k] = off + pre[i];
          if (sg == 7) GC[k] = __expf(off + pre[7]); }
        __syncthreads();
        { float cl[8], cm[8];
          lds_ld8(WPRE + s_ * 64 + cg * 8, cl);
          if (s_ > 0) lds_ld8(WPRE + (s_ - 1) * 64 + cg * 8, cm);
          else {
#pragma unroll
              for (int e = 0; e < 8; ++e) cm[e] = 0.f; }
          float o1[8], o2[8], o3[8], o4[8];
#pragma unroll
          for (int e = 0; e < 8; ++e) { const float ep = __expf(cl[e]), en = __expf(-cl[e]); o1[e] = kkn[e] * __expf(cm[e]); o2[e] = r8[e] * ep; o3[e] = bb[e] * en; o4[e] = kd[e] * en; }
          *(LAS u32x4*)(lds + SL(S_KT) + s_ * P144 + cg * 16) = pack8(o1); *(LAS u32x4*)(lds + SL(S_RT) + s_ * P144 + cg * 16) = pack8(o2);
          *(LAS u32x4*)(lds + SL(S_BH) + s_ * P144 + cg * 16) = pack8(o3); *(LAS u32x4*)(lds + SL(S_KH) + s_ * P144 + cg * 16) = pack8(o4); }
        __syncthreads();
#define FRW(slot, r0, ks) frag_row(lds + (slot), P144, (r0), (ks), lane)
#define FCL(slot, c0_, ks) frag_col(lds + (slot), P144, (c0_), (ks), lane)
#define MMA_(acc_, a_, b_) acc_ = __builtin_amdgcn_mfma_f32_16x16x32_bf16((b_), (a_), (acc_), 0, 0, 0)
        const int r0 = 16 * tr; const int cc[2] = {16 * tc0, 16 * tc0 + 16};
        f32x4 accG[2], accX[2], accY[2];
        { bf16x8 aKT[2], aRT[2], aS0[2];
#pragma unroll
          for (int ks = 0; ks < 2; ++ks) { aKT[ks] = FRW(SL(S_KT), r0, ks); aRT[ks] = FRW(SL(S_RT), r0, ks); aS0[ks] = FRW(SL(S_S0B), r0, ks); }
          f32x4 aab[2], aak[2], arb[2], ark[2];
#pragma unroll
          for (int jn = 0; jn < 2; ++jn) { aab[jn] = aak[jn] = arb[jn] = ark[jn] = accX[jn] = accY[jn] = (f32x4){0.f, 0.f, 0.f, 0.f};
#pragma unroll
              for (int ks = 0; ks < 2; ++ks) { const bf16x8 bBH = FRW(SL(S_BH), cc[jn], ks), bKH = FRW(SL(S_KH), cc[jn], ks), bKT = FRW(SL(S_KT), cc[jn], ks), bS0 = FRW(SL(S_S0B), cc[jn], ks);
                  MMA_(aab[jn], aKT[ks], bBH); MMA_(aak[jn], aKT[ks], bKH); MMA_(arb[jn], aRT[ks], bBH); MMA_(ark[jn], aRT[ks], bKH); MMA_(accX[jn], aS0[ks], bKT); MMA_(accY[jn], aRT[ks], bS0); } }
#pragma unroll
          for (int jn = 0; jn < 2; ++jn) { const int col = cc[jn] + 4 * fq;
#pragma unroll
              for (int e = 0; e < 4; ++e) { const bool lo = mrow > col + e, le = mrow >= col + e;
                  aab[jn][e] = lo ? aab[jn][e] : 0.f; aak[jn][e] = lo ? aak[jn][e] : 0.f; arb[jn][e] = le ? arb[jn][e] : 0.f; ark[jn][e] = le ? ark[jn][e] : 0.f;
                  accG[jn][e] = (mrow == col + e ? 1.0f : 0.f) - aab[jn][e]; }
              st_bf4(lds + SL(S_LA), mrow, col, aab[jn]); st_bf4(lds + SL(S_GA), mrow, col, accG[jn]);
              st_bf4(lds + SL(S_AAK), mrow, col, aak[jn]); st_bf4(lds + SL(S_ARB), mrow, col, arb[jn]); st_bf4(lds + SL(S_ARK), mrow, col, ark[jn]); } }
        __syncthreads();
        __builtin_amdgcn_sched_barrier(0);
        { const int j1 = j + 1 < 132 ? j + 1 : 131; SCAN_GEOM(j1) SCAN_ISSUE(); }
        __builtin_amdgcn_sched_barrier(0);
        { bf16x8 aLA[2], aV[2], aARK[2]; f32x4 l[2];
#pragma unroll
          for (int ks = 0; ks < 2; ++ks) { aLA[ks] = FRW(SL(S_LA), r0, ks); aV[ks] = FCL(vsl, r0, ks); aARK[ks] = FRW(SL(S_ARK), r0, ks); }
#pragma unroll
          for (int jn = 0; jn < 2; ++jn) { l[jn] = (f32x4){0.f, 0.f, 0.f, 0.f};
#pragma unroll
              for (int ks = 0; ks < 2; ++ks) { const bf16x8 bLA = FCL(SL(S_LA), cc[jn], ks), bAAK = FRW(SL(S_AAK), cc[jn], ks), bV = FCL(vsl, cc[jn], ks);
                  MMA_(l[jn], aLA[ks], bLA); MMA_(accX[jn], aV[ks], bAAK); MMA_(accY[jn], aARK[ks], bV); } }
#pragma unroll
          for (int jn = 0; jn < 2; ++jn) { st_bf4(lds + SL(S_KT), mrow, cc[jn] + 4 * fq, l[jn]); st_bf4(lds + SL(S_TW), mrow, cc[jn] + 4 * fq, accX[jn]); } }
        __syncthreads();
#pragma unroll
        for (int st = 1; st <= 4; ++st) {
            const int lsrc = (st & 1) ? SL(S_KT) : SL(S_LA), ldst = (st & 1) ? SL(S_LA) : SL(S_KT), gsrc = (st & 1) ? SL(S_GA) : SL(S_RT), gdst = (st & 1) ? SL(S_RT) : SL(S_GA);
            bf16x8 aL[2], aG[2]; f32x4 l[2];
#pragma unroll
            for (int ks = 0; ks < 2; ++ks) { aL[ks] = FRW(lsrc, r0, ks); aG[ks] = FRW(gsrc, r0, ks); }
#pragma unroll
            for (int jn = 0; jn < 2; ++jn) { l[jn] = (f32x4){0.f, 0.f, 0.f, 0.f};
#pragma unroll
                for (int ks = 0; ks < 2; ++ks) { const bf16x8 bL = FCL(lsrc, cc[jn], ks); MMA_(l[jn], aL[ks], bL); MMA_(accG[jn], aG[ks], bL); } }
#pragma unroll
            for (int jn = 0; jn < 2; ++jn) { st_bf4(lds + ldst, mrow, cc[jn] + 4 * fq, l[jn]); st_bf4(lds + gdst, mrow, cc[jn] + 4 * fq, accG[jn]); }
            __syncthreads();
        }
        { bf16x8 aG[2];
#pragma unroll
          for (int ks = 0; ks < 2; ++ks) aG[ks] = FRW(SL(S_GA), r0, ks);
#pragma unroll
          for (int jn = 0; jn < 2; ++jn) {
#pragma unroll
              for (int ks = 0; ks < 2; ++ks) { const bf16x8 bL = FCL(SL(S_KT), cc[jn], ks); MMA_(accG[jn], aG[ks], bL); } }
#pragma unroll
          for (int jn = 0; jn < 2; ++jn) st_bf4(lds + SL(S_RT), mrow, cc[jn] + 4 * fq, accG[jn]); }
        __syncthreads();
        { bf16x8 aX[2]; f32x4 u[2];
#pragma unroll
          for (int ks = 0; ks < 2; ++ks) aX[ks] = FRW(SL(S_TW), r0, ks);
#pragma unroll
          for (int jn = 0; jn < 2; ++jn) { u[jn] = (f32x4){0.f, 0.f, 0.f, 0.f};
#pragma unroll
              for (int ks = 0; ks < 2; ++ks) { const bf16x8 bT = FRW(SL(S_RT), cc[jn], ks); MMA_(u[jn], aX[ks], bT); } }
#pragma unroll
          for (int jn = 0; jn < 2; ++jn) st_bf4(lds + SL(S_AD), mrow, cc[jn] + 4 * fq, -u[jn]); }
        __builtin_amdgcn_sched_barrier(0);
        SCAN_STEP1(vnx);
        __syncthreads();
        { bf16x8 aUT[2], aV[2], aARB[2];
#pragma unroll
          for (int ks = 0; ks < 2; ++ks) { aUT[ks] = FRW(SL(S_AD), r0, ks); aV[ks] = FCL(vsl, r0, ks); aARB[ks] = FRW(SL(S_ARB), r0, ks); }
#pragma unroll
          for (int jn = 0; jn < 2; ++jn) {
#pragma unroll
              for (int ks = 0; ks < 2; ++ks) { const bf16x8 bBH = FCL(SL(S_BH), cc[jn], ks), bKH = FCL(SL(S_KH), cc[jn], ks), bUT = FRW(SL(S_AD), cc[jn], ks);
                  MMA_(accS[jn], aUT[ks], bBH); MMA_(accS[jn], aV[ks], bKH); MMA_(accY[jn], aARB[ks], bUT); } }
#pragma unroll
          for (int jn = 0; jn < 2; ++jn) { const int col = cc[jn] + 4 * fq;
            accS[jn] *= *(const LAS f32x4*)(GC + col);
            st_bf4(lds + SL(S_S0B), mrow, col, accS[jn]);
            const int post = dir ? L - 1 - (64 * jl + mrow) : 64 * jl + mrow;
            { u32x2 w; w.x = pk2(accY[jn][0], accY[jn][1]); w.y = pk2(accY[jn][2], accY[jn][3]); *(u32x2*)(yout + (size_t)(rowbase + post) * RWW + h * 64 + col) = w; } } }
        SCAN_LORA();
#undef FRW
#undef FCL
#undef MMA_
        __syncthreads();
    }
}

__device__ __forceinline__ float lerp1(const bf16_t* zs, bool isctx, int ac, int pos, int row, float mu) {
    bool valid; const int nr = shift_nbr(isctx, ac, pos, row, valid);
    const float a = __builtin_bit_cast(float, (unsigned)zs[(size_t)row * ZW + Z_RW + ac] << 16);
    const float b = valid ? __builtin_bit_cast(float, (unsigned)zs[(size_t)nr * ZW + Z_RW + ac] << 16) : 0.f;
    return a + (b - a) * mu;
}
__device__ __forceinline__ void phase_scan_naive(const Params& p, int li, LAS unsigned char* lds, const int q) {
    int tidn = threadIdx.x; asm volatile("" : "+v"(tidn)); const int lane = tidn & 63;
    if (tidn >= 64) return;
    const int dir = q & 1, h = (q >> 1) & 15, b = q >> 5;
    const bf16_t* zs = (const bf16_t*)(p.ws + WS_A);
    bf16_t* yout = (bf16_t*)(p.ws + (dir ? WS_Y1 : WS_Y0));
    float* bon = (float*)(p.ws + WS_BON) + (size_t)dir * NROW * 16;
    LAS float* V = (LAS float*)lds;
    const int c = h * 64 + lane;
    const float* mu = p.in[I_MU] + (size_t)li * RW_COLS;
    const float w0 = p.in[I_W0][(size_t)(li * 2 + dir) * RWW + c], a0 = p.in[I_A0][(size_t)(li * 2 + dir) * RWW + c];
    const float pkk = p.in[I_KK][(size_t)li * RWW + c], pka = p.in[I_KA][(size_t)li * RWW + c], prk = p.in[I_RK][(size_t)li * RWW + c];
    const float mur = mu[c], muk = mu[1024 + c], muv = mu[2048 + c], muw = mu[3072 + dir * 64 + lane], mua = mu[3072 + 128 + dir * 64 + lane];
    float S[64]; LAS float* WU = V + 512; LAS float* AU = V + 512 + 4096;
#pragma unroll
    for (int j = 0; j < 64; ++j) { WU[j * 64 + lane] = p.in[I_WUP][((size_t)(li * 2 + dir) * 64 + j) * RWW + c]; AU[j * 64 + lane] = p.in[I_AUP][((size_t)(li * 2 + dir) * 64 + j) * RWW + c]; S[j] = 0.f; }
    for (int t = 0; t < CTXL + SEQ; ++t) {
        const bool isctx = t < CTXL; const int tl = isctx ? t : t - CTXL; const int L = isctx ? CTXL : SEQ; const int rowbase = isctx ? RLAT + b * CTXL : b * SEQ;
        const int pos = dir ? L - 1 - tl : tl; const int row = rowbase + pos;
        const float r = lerp1(zs, isctx, c, pos, row, mur), kx = lerp1(zs, isctx, 1024 + c, pos, row, muk), v = lerp1(zs, isctx, 2048 + c, pos, row, muv);
        const float tw = tanhf_(lerp1(zs, isctx, 3072 + dir * 64 + lane, pos, row, muw)), ad = lerp1(zs, isctx, 3072 + 128 + dir * 64 + lane, pos, row, mua);
        asm volatile("s_waitcnt lgkmcnt(0)" ::: "memory");
        V[lane] = tw; V[64 + lane] = ad;
        asm volatile("s_waitcnt lgkmcnt(0)" ::: "memory");
        float wp = w0, ap = a0;
#pragma unroll
        for (int j = 0; j < 64; ++j) { wp += V[j] * WU[j * 64 + lane]; ap += V[64 + j] * AU[j * 64 + lane]; }
        const float wdec = __expf(-0.60653066f * sigmoidf_(wp)), a = sigmoidf_(ap);
        float kk = kx * pkk; const float n2 = wave_sum(kk * kk); kk = kk / fmaxf(sqrtf(n2), 1e-12f);
        const float kd = kx * (1.0f + (a - 1.0f) * pka), bb = kk * a;
        const float bs = wave_sum(r * kd * prk);
        if (lane == 0) bon[(size_t)row * 16 + h] = bs;
        V[128 + lane] = wdec; V[192 + lane] = kk; V[256 + lane] = bb; V[320 + lane] = kd; V[384 + lane] = r;
        asm volatile("s_waitcnt lgkmcnt(0)" ::: "memory");
        float sa = 0.f;
#pragma unroll
        for (int k = 0; k < 64; ++k) sa -= S[k] * V[192 + k];
        float y = 0.f;
#pragma unroll
        for (int k = 0; k < 64; ++k) { S[k] = S[k] * V[128 + k] + sa * V[256 + k] + v * V[320 + k]; y += S[k] * V[384 + k]; }
        yout[(size_t)row * RWW + c] = (bf16_t)f2bf(y);
    }
}

__device__ __forceinline__ void post_unit(const Params& p, int li, int tb, int sl, LAS unsigned char* lds, const bool load_gu) {
    int tid = threadIdx.x; asm volatile("" : "+v"(tid)); const int lane = tid & 63, wave = tid >> 6;
    LAS unsigned char* SG = lds;
    LAS unsigned char* GU = lds + 64 * P272;
    const bf16_t* zs = (const bf16_t*)(p.ws + WS_A);
    const bf16_t* yf = (const bf16_t*)(p.ws + WS_Y0); const bf16_t* yb = (const bf16_t*)(p.ws + WS_Y1);
    const float* bon = (const float*)(p.ws + WS_BON);
    bf16_t* yc = (bf16_t*)(p.ws + WS_YC);
    const float* mu = p.in[I_MU] + (size_t)li * RW_COLS;
    const int row0 = tb * 64; const bool isctx = row0 >= RLAT;
    if (load_gu) { const int j = tid >> 2, c0 = (tid & 3) * 32; const float* src = p.in[I_GUP] + ((size_t)li * 128 + j) * RWW + sl * 128 + c0;
#pragma unroll
      for (int i = 0; i < 4; ++i) { const f32x4 a = *(const f32x4*)(src + 8 * i), b = *(const f32x4*)(src + 8 * i + 4);
          u32x4 w; w.x = pk2(a[0], a[1]); w.y = pk2(a[2], a[3]); w.z = pk2(b[0], b[1]); w.w = pk2(b[2], b[3]);
          *(LAS u32x4*)(GU + j * P272 + (c0 + 8 * i) * 2) = w; } }
    { const int t = tid >> 3, cgp = tid & 7; const int row = row0 + t; const int pos = isctx ? ((row - RLAT) & (CTXL - 1)) : (row & (SEQ - 1));
#pragma unroll
      for (int i = 0; i < 2; ++i) { const int jj = 16 * cgp + 8 * i; float m8[8], g8[8];
#pragma unroll
          for (int e = 0; e < 8; ++e) m8[e] = mu[3328 + jj + e];
          load_lerp8(zs, isctx, 3328 + jj, pos, row, m8, g8);
#pragma unroll
          for (int e = 0; e < 8; ++e) g8[e] = sigmoidf_(g8[e]);
          *(LAS u32x4*)(SG + t * P272 + jj * 2) = pack8(g8); } }
    __syncthreads();
    { const int tr = wave >> 1, hs = wave & 1, fr = lane & 15, fq = lane >> 4;
      f32x4 acc[4];
#pragma unroll
      for (int jn = 0; jn < 4; ++jn) { acc[jn] = zero4(); mm16<false, true, 4>(acc[jn], SG, P272, 16 * tr, GU, P272, 64 * hs + 16 * jn, lane); }
      const int row = row0 + 16 * tr + fr, head = sl * 2 + hs; const int pos = isctx ? ((row - RLAT) & (CTXL - 1)) : (row & (SEQ - 1));
      f32x4 y[4]; float s = 0.f;
#pragma unroll
      for (int jn = 0; jn < 4; ++jn) { const int c = head * 64 + 16 * jn + 4 * fq; { const u32x2 a = *(const u32x2*)(yf + (size_t)row * RWW + c), b = *(const u32x2*)(yb + (size_t)row * RWW + c); y[jn] = (f32x4){bf_lo(a.x) + bf_lo(b.x), bf_hi(a.x) + bf_hi(b.x), bf_lo(a.y) + bf_lo(b.y), bf_hi(a.y) + bf_hi(b.y)}; } s += (y[jn][0] + y[jn][1]) + (y[jn][2] + y[jn][3]); }
      s += __shfl_xor(s, 16); s += __shfl_xor(s, 32);
      const float mean = s * (1.0f / 64.0f); float qv = 0.f;
#pragma unroll
      for (int jn = 0; jn < 4; ++jn) { const f32x4 d = y[jn] - mean; qv += (d[0] * d[0] + d[1] * d[1]) + (d[2] * d[2] + d[3] * d[3]); }
      qv += __shfl_xor(qv, 16); qv += __shfl_xor(qv, 32);
      const float rstd = 1.0f / sqrtf(qv * (1.0f / 64.0f) + 64e-5f);
      const float bonus = DBG == 5 ? 0.f : bon[(size_t)row * 16 + head] + bon[(size_t)NROW * 16 + (size_t)row * 16 + head];
#pragma unroll
      for (int jn = 0; jn < 4; ++jn) { const int c = head * 64 + 16 * jn + 4 * fq, ac = 2048 + c;
          bool valid; const int nr = shift_nbr(isctx, ac, pos, row, valid);
          const u32x2 zw = *(const u32x2*)(zs + (size_t)row * ZW + Z_RW + ac); u32x2 nw = {0u, 0u};
          if (valid) nw = *(const u32x2*)(zs + (size_t)nr * ZW + Z_RW + ac);
          const f32x4 m4 = *(const f32x4*)(mu + ac), lg = *(const f32x4*)(p.in[I_LNG] + (size_t)li * RWW + c), lb = *(const f32x4*)(p.in[I_LNB] + (size_t)li * RWW + c);
          const f32x4 zv = {bf_lo(zw.x), bf_hi(zw.x), bf_lo(zw.y), bf_hi(zw.y)}, nv = {bf_lo(nw.x), bf_hi(nw.x), bf_lo(nw.y), bf_hi(nw.y)};
          const f32x4 v = zv + (nv - zv) * m4;
          const f32x4 o = ((y[jn] - mean) * rstd * lg + lb + v * bonus) * acc[jn];
          u32x2 w; w.x = pk2(o[0], o[1]); w.y = pk2(o[2], o[3]);
          *(u32x2*)(yc + ycb(row, 512 + c)) = w; } }
    __syncthreads();
}

constexpr size_t WS_DBG = 32768;
__device__ __forceinline__ unsigned hash32(unsigned x) { x ^= x >> 16; x *= 0x7feb352dU; x ^= x >> 15; x *= 0x846ca68bU; x ^= x >> 16; return x; }
__device__ __forceinline__ float bf2f(bf16_t v) { return __builtin_bit_cast(float, (unsigned)v << 16); }
__device__ __forceinline__ void dbg_put(const Params& p, int id, float ref, float got, float scale) {
    float e = fabsf(got - ref) / (fabsf(ref) + scale);
    if (!(e == e)) e = 1e6f;
    if (e > 0.1f) atomicAdd((unsigned*)(p.ws + WS_DBG) + id, 1u);
}
__device__ __forceinline__ const float* dbg_xrow(const Params& p, int row, bool from_input) {
    return row < RLAT ? (from_input ? p.in[I_X] : p.out) + (size_t)row * D : (from_input ? p.in[I_CTX] : (const float*)(p.ws + WS_HC)) + (size_t)(row - RLAT) * D;
}
#ifndef DBGBUCKET
#define DBGBUCKET 1
#endif
#ifndef DBGLAYER
#define DBGLAYER 0
#endif
__device__ __forceinline__ void dbg_check(const Params& p, int id) {
    constexpr int li = DBGLAYER;
    int tq = threadIdx.x; asm volatile("" : "+v"(tq)); const unsigned sidx = blockIdx.x * 512 + tq;
    const int NS = (id == 9) ? 1024 : ((id == 5 || id == 15 || id == 4) ? 131072 : 8192);
    if ((int)sidx >= NS) return;
    const int hid = id == 70 ? 7 : (id == 110 ? 11 : id); const unsigned h1 = hash32(sidx * 2654435761u + hid * 97u), h2 = hash32(h1 + 0x9e3779b9u);
    unsigned char* ws = p.ws; asm volatile("" : "+s"(ws));
    const float* mod = (const float*)(ws + WS_MOD) + (size_t)li * NCOND * NMOD * D;
    const float* mod0 = (const float*)(ws + WS_MOD);
    const bf16_t* hn = (const bf16_t*)p.out; const bf16_t* hb = (const bf16_t*)(ws + WS_A); const bf16_t* zs = (const bf16_t*)(ws + WS_A); const bf16_t* gates = (const bf16_t*)(ws + WS_B); const bf16_t* yc = (const bf16_t*)(ws + WS_YC);
    const int row = h1 % NROW, cond = row_cond(row);
    if (id == 0) {
        const int l = h1 & 1, cd = (h1 >> 1) % NCOND, col = h2 % (NMOD * D);
        float s = p.in[I_ADAB][(size_t)l * NMOD * D + col];
        for (int k = 0; k < D; ++k) { const float v = cd < 4 ? p.in[I_C][cd * D + k] : p.in[I_CCTX][k]; s += siluf_(v) * p.in[I_ADAW][((size_t)l * D + k) * (NMOD * D) + col]; }
        dbg_put(p, id, s, mod0[((size_t)l * NCOND + cd) * (NMOD * D) + col], 0.3f);
    } else if (id == 1) {
        const int col = h2 % D; const float* xr = dbg_xrow(p, row, li == 0); float ss = 0.f;
        for (int k = 0; k < D; ++k) ss += xr[k] * xr[k];
        const float rstd = 1.0f / sqrtf(ss / D + 1e-6f);
        const float ref = xr[col] * rstd * p.in[I_NORMG][(size_t)li * 3 * D + col] * (1.0f + mod[((size_t)cond * NMOD + 1) * D + col]) + mod[((size_t)cond * NMOD + 0) * D + col];
        dbg_put(p, id, ref, bf2f(hn[(size_t)row * D + col]), 1.0f);
    } else if (id == 2) {
        const int j = h2 % FF; float g = 0.f, u = 0.f;
        for (int k = 0; k < D; ++k) { const float a = bf2f(hn[(size_t)row * D + k]); g += a * p.in[I_WG][(size_t)li * 2 * D * FF + (size_t)k * FF + j]; u += a * p.in[I_WU][(size_t)li * 2 * D * FF + (size_t)k * FF + j]; }
        dbg_put(p, id, siluf_(g) * u, bf2f(hb[(size_t)row * FF + j]), 0.5f);
    } else if (id == 3 && li == 0) {
        const int col = h2 % D; float s = 0.f;
        for (int k = 0; k < FF; ++k) s += bf2f(hb[(size_t)row * FF + k]) * p.in[I_WD][(size_t)k * D + col];
        const float ref = dbg_xrow(p, row, true)[col] + 0.5f * mod[((size_t)cond * NMOD + 2) * D + col] * s;
        dbg_put(p, id, ref, dbg_xrow(p, row, false)[col], 1.0f);
    } else if (id == 4) {
        int zc = h2 % ZW; if (zc >= 3968 && zc < 4096) zc = 100; const int src = zc < 3968 ? zc : zc - 128; float s = 0.f;
        for (int k = 0; k < D; ++k) s += bf2f(hn[(size_t)row * D + k]) * p.in[I_WIN][(size_t)li * D * IN_COLS + (size_t)k * IN_COLS + src];
        if (fabsf(s - bf2f(zs[(size_t)row * ZW + zc])) > 0.1f) atomicAdd((unsigned*)(p.ws + WS_DBG) + 4, 1u);
    } else if (id == 5) {
        const int gc = h2 % GW; float s = 0.f;
        for (int k = 0; k < D; ++k) s += bf2f(hn[(size_t)row * D + k]) * p.in[I_WIN][(size_t)li * D * IN_COLS + (size_t)k * IN_COLS + 4992 + gc];
        { const float ref_ = sigmoidf_(s), got_ = bf2f(gates[(size_t)row * GW + gc]); if (fabsf(got_ - ref_) / (fabsf(ref_) + 0.5f) > 0.1f) { atomicAdd((unsigned*)(p.ws + WS_DBG) + 5, 1u); atomicAdd((unsigned*)(p.ws + WS_DBG) + 32 + (DBGBUCKET ? gc / 32 : row / 256), 1u); } }
    } else if (id == 6) {
        const int col = h2 % D; float tot = 0.f;
        for (int br = 0; br < 3; ++br) { const int koff = br == 0 ? 0 : (br == 1 ? 512 : 1536), kk = br == 1 ? 1024 : 512; const float* pr = br == 0 ? p.in[I_PP] + (size_t)li * 512 * D : (br == 1 ? p.in[I_PR] + (size_t)li * 1024 * D : p.in[I_PG] + (size_t)li * 512 * D); float s = 0.f;
            for (int k = 0; k < kk; ++k) s += bf2f(yc[(size_t)row * D + koff + k]) * pr[(size_t)k * D + col];
            tot += s * bf2f(gates[(size_t)row * GW + br * D + col]); }
        dbg_put(p, id, tot, bf2f(hn[(size_t)row * D + col]), 0.5f);
    } else if (id == 8) {
        const int d = h2 % 512, g = d >> 7, half = 1 << g; const int L = row < RLAT ? SEQ : CTXL, pos = row < RLAT ? (row & (SEQ - 1)) : ((row - RLAT) & (CTXL - 1)); float s = 0.f;
        const int lo = pos - half < 0 ? 0 : pos - half, hi = pos + half > L ? L : pos + half;
        for (int c = 0; c < 128; ++c) { float w = 0.f; for (int u = lo; u < hi; ++u) w += bf2f(zs[(size_t)(row - pos + u) * ZW + g * 128 + c]);
            const float pv = w / (float)(hi - lo) - bf2f(zs[(size_t)row * ZW + g * 128 + c]); s += pv * p.in[I_POOLW][(size_t)li * 4 * 128 * 128 + ((size_t)g * 128 + c) * 128 + (d & 127)]; }
        dbg_put(p, id, s * p.in[I_POOLS][li * 512 + d], bf2f(yc[(size_t)row * D + d]), 0.7f);
    } else if (id == 9) {
        const int cc = h2 % 512, g = cc >> 7; const int t = row & 127, r0 = row - t; float s = p.in[I_GBS][li * 512 + g * 128 + t];
        for (int sx = 0; sx < 128; ++sx) { const bf16_t* zr = zs + (size_t)(r0 + sx) * ZW + Z_GV; float m = 0.f;
            for (int c = 0; c < 512; ++c) m += gelu_tanh(bf2f(zr[c]));
            m *= (1.0f / 512.0f); float q = 0.f;
            for (int c = 0; c < 512; ++c) { const float d = gelu_tanh(bf2f(zr[c])) - m; q += d * d; }
            const float vn = (gelu_tanh(bf2f(zr[cc])) - m) / sqrtf(q / 512.0f + 1e-5f) * p.in[I_GLNG][li * 512 + cc] + p.in[I_GLNB][li * 512 + cc];
            s += p.in[I_GWS][(size_t)li * 4 * 128 * 128 + ((size_t)g * 128 + t) * 128 + sx] * vn; }
        dbg_put(p, id, gelu_tanh(bf2f(zs[(size_t)row * ZW + Z_GU + cc])) * s, bf2f(yc[(size_t)row * D + 1536 + cc]), 0.7f);
    } else if (id == 10) {
        const int c = h2 % RWW, head = c >> 6; const bool isctx = row >= RLAT; const int pos = isctx ? ((row - RLAT) & (CTXL - 1)) : (row & (SEQ - 1));
        const bf16_t* yf_ = (const bf16_t*)(ws + WS_Y0); const bf16_t* yb_ = (const bf16_t*)(ws + WS_Y1); const float* bon = (const float*)(ws + WS_BON); const float* mu = p.in[I_MU] + (size_t)li * RW_COLS;
#define yf(i_) bf2f(yf_[i_])
#define yb(i_) bf2f(yb_[i_])
        float m = 0.f; for (int k = 0; k < 64; ++k) m += yf((size_t)row * RWW + head * 64 + k) + yb((size_t)row * RWW + head * 64 + k);
        m *= (1.0f / 64.0f); float q = 0.f;
        for (int k = 0; k < 64; ++k) { const float d = yf((size_t)row * RWW + head * 64 + k) + yb((size_t)row * RWW + head * 64 + k) - m; q += d * d; }
        const float yn = (yf((size_t)row * RWW + c) + yb((size_t)row * RWW + c) - m) / sqrtf(q / 64.0f + 64e-5f) * p.in[I_LNG][li * RWW + c] + p.in[I_LNB][li * RWW + c];
        const float v = lerp1(zs, isctx, 2048 + c, pos, row, mu[2048 + c]); float g = 0.f;
        for (int j = 0; j < 128; ++j) g += sigmoidf_(lerp1(zs, isctx, 3328 + j, pos, row, mu[3328 + j])) * p.in[I_GUP][(size_t)li * 128 * RWW + (size_t)j * RWW + c];
        const float bonus = bon[(size_t)row * 16 + head] + bon[(size_t)NROW * 16 + (size_t)row * 16 + head];
        dbg_put(p, id, (yn + bonus * v) * g, bf2f(yc[(size_t)row * D + 512 + c]), 0.7f);
    } else if (id == 70 || id == 110) {
        const int col = h2 % D; ((float*)(ws + 65536 + 4 * MiB * 0))[sidx] = dbg_xrow(p, row, false)[col];
    } else if (id == 7) {
        const int col = h2 % D; float s = 0.f;
        for (int k = 0; k < D; ++k) s += bf2f(hn[(size_t)row * D + k]) * p.in[I_WOUT][(size_t)li * D * D + (size_t)k * D + col];
        const float ref = ((const float*)(ws + 65536))[sidx] + mod[((size_t)cond * NMOD + 5) * D + col] * s;
        dbg_put(p, id, ref, dbg_xrow(p, row, false)[col], 1.0f);
    } else if (id == 11) {
        const int col = h2 % D; float s = 0.f;
        for (int k = 0; k < FF; ++k) s += bf2f(hb[(size_t)row * FF + k]) * p.in[I_WD][(size_t)(li * 2 + 1) * FF * D + (size_t)k * D + col];
        const float ref = ((const float*)(ws + 65536))[sidx] + 0.5f * mod[((size_t)cond * NMOD + 8) * D + col] * s;
        dbg_put(p, id, ref, dbg_xrow(p, row, false)[col], 1.0f);
    } else if (id == 12 || id == 13) {
        const int which = id - 11; const int col = h2 % D; const float* xr = dbg_xrow(p, row, false); float ss = 0.f;
        for (int k = 0; k < D; ++k) ss += xr[k] * xr[k];
        const float rstd = 1.0f / sqrtf(ss / D + 1e-6f);
        const float ref = xr[col] * rstd * p.in[I_NORMG][(size_t)(li * 3 + which) * D + col] * (1.0f + mod[((size_t)cond * NMOD + 3 * which + 1) * D + col]) + mod[((size_t)cond * NMOD + 3 * which) * D + col];
        dbg_put(p, id, ref, bf2f(hn[(size_t)row * D + col]), 1.0f);
    } else if (id == 14) {
        const int j = h2 % FF; float g = 0.f, u = 0.f;
        for (int k = 0; k < D; ++k) { const float a = bf2f(hn[(size_t)row * D + k]); g += a * p.in[I_WG][(size_t)(li * 2 + 1) * D * FF + (size_t)k * FF + j]; u += a * p.in[I_WU][(size_t)(li * 2 + 1) * D * FF + (size_t)k * FF + j]; }
        dbg_put(p, id, siluf_(g) * u, bf2f(hb[(size_t)row * FF + j]), 0.5f);
    } else if (id == 15) {
        const int drow = h1 % NWIN, k = h2 % D; const bf16_t got = ((const bf16_t*)(ws + W_IN))[(size_t)drow * D + k];
        const int c = drow < 3968 ? drow : drow - 128; float ref = (drow >= 3968 && drow < 4096) ? 0.f : p.in[I_WIN][(size_t)li * D * IN_COLS + (size_t)k * IN_COLS + c];
        if (fabsf(bf2f(got) - ref) > 0.01f * fabsf(ref) + 1e-6f) atomicAdd((unsigned*)(p.ws + WS_DBG) + 15, 1u);
    }
}

constexpr int PH_PER_LAYER = 14, PH_FINAL = DEPTH * PH_PER_LAYER, PH_TOTAL = PH_FINAL + 1;
__global__ void __launch_bounds__(512, 2) mk_fwd(Params p) {
    extern __shared__ __attribute__((aligned(16))) unsigned char lds_raw[];
    LAS unsigned char* lds = (LAS unsigned char*)lds_raw;
    const int tid = threadIdx.x, G = gridDim.x, bx = blockIdx.x;
    if (tid == 0) *(LAS u32x4*)(lds + LDS_BARW) = (u32x4){0u, 0u, 0u, 0u};
    __syncthreads();
    XcdBarrier bar; bar.bar = (unsigned*)(p.ws + WS_CTL); bar.x = 0; bar.st = (volatile LAS unsigned*)(lds + LDS_BARW);
    if (!MK_MULTI) bar = xcd_barrier_post((unsigned*)(p.ws + WS_CTL), (volatile LAS unsigned*)(lds + LDS_BARW));
    const int lo = p.ph_lo, hi = p.ph_hi;
#ifndef PHASE_MASK
#define PHASE_MASK 0x7fffffff
#endif
#define PHEN(k) (((PHASE_MASK) >> ((k) % PH_PER_LAYER)) & 1)
#define IN(k) (PHEN(k) && lo <= (k) && (k) < hi)
#define SEAM(k) do { if (IN((k) + 1)) xcd_barrier(bar); } while (0)
#define REPS(k) for (int rep = 0; rep < 1 + (((REPMASK) >> (k)) & 1); ++rep)
#define DCHK(id) do { if (DBGCHK && li == DBGLAYER) { dbg_check(p, (id)); xcd_barrier(bar); } } while (0)
#define WSP unsigned char* ws = p.ws; asm volatile("" : "+s"(ws)); bf16_t* hn = (bf16_t*)p.out; bf16_t* ycat = (bf16_t*)(ws + WS_YC); bf16_t* hbuf = (bf16_t*)(ws + WS_A); bf16_t* zs = (bf16_t*)(ws + WS_A); \
    float* mtmp = (float*)(ws + WS_A); bf16_t* gates = (bf16_t*)(ws + WS_B); float* hc = (float*)(ws + WS_HC); const float* modl = (const float*)(ws + WS_MOD) + (size_t)li * NCOND * NMOD * D; \
    const float* xs_lat = li == 0 ? p.in[I_X] : p.out; const float* xs_ctx = li == 0 ? p.in[I_CTX] : hc; (void)hn; (void)ycat; (void)hbuf; (void)zs; (void)mtmp; (void)gates; (void)hc; (void)modl; (void)xs_lat; (void)xs_ctx;
    for (int li = 0; li < DEPTH; ++li) {
        const int pb = li * PH_PER_LAYER;
        const bool early = (G == 256) && (DEPTH == 2);
        const int MR = (li == DEPTH - 1) ? RLAT : NROW;
        if (IN(pb + 0)) { REPS(0) { phase_conv(p, li, lds, (early && li > 0) ? CV_NEARLY : 0, CV_NITEMS, bx, G, (bf16_t*)(p.ws + W_GU0), (bf16_t*)(p.ws + W_D0), true); if (li == 0) { __syncthreads(); phase_ada(p, lds); } __syncthreads(); } if (li == 0) SEAM(pb + 0); }
        if (IN(pb + 1)) { DCHK(0); DCHK(15); WSP REPS(1) phase_norm(p, li, 0, li == 0 ? p.in[I_X] : nullptr, xs_ctx, NROW, li == 0, li > 0); SEAM(pb + 1); }
        if (IN(pb + 2)) { DCHK(1); WSP pg8::Gemm g = pg8::mkgemm_blk(hn, (early && li > 0) ? (const bf16_t*)((const unsigned char*)p.out + EARLY_GU0) : (const bf16_t*)(ws + W_GU0), NROW, NGU, D); pg8::StaticOrder S; S.init(NROW, NGU, G, bx); pg8::EpiGU E{hbuf};
            REPS(2) { pg8::gemm_phase(lds, g, S, E); __syncthreads(); } SEAM(pb + 2); }
        if (IN(pb + 3)) { DCHK(2); WSP pg8::Gemm g = pg8::mkgemm_blk(hbuf, (early && li > 0) ? (const bf16_t*)((const unsigned char*)p.out + EARLY_D0) : (const bf16_t*)(ws + W_D0), NROW, D, FF); pg8::CtxSplitOrder S; S.init(NROW, D, G, bx); S.wgm = 4; REPS(3) { pg8::EpiResB E{(bf16_t*)(ws + WS_XB), (float*)((unsigned char*)p.out + CTXP_OFF), modl + 2 * D, rep ? 0.0f : 0.5f}; pg8::gemm_phase(lds, g, S, E); if (REPMASK) xcd_barrier(bar); } SEAM(pb + 3); }
        if (IN(pb + 4)) { DCHK(3); WSP REPS(4) phase_norm(p, li, 1, nullptr, hc, NROW, false, true); SEAM(pb + 4); }
        const int ZFILL = (G >= 256) ? (G - (NROW / 256) * 14 % G) % G : 0;
        if (IN(pb + 5)) { DCHK(12); WSP pg8::Gemm g = pg8::mkgemm_blk(hn, (const bf16_t*)(ws + W_IN), NROW, ZW, D); pg8::W1Order S; S.R.init(NROW, G >= 256 ? 3584 : ZW, G, bx); S.R.lo = 0; S.R.sh = G >= 256 ? 2 : 0; S.nR = S.R.nwg;
            S.Z.init(MR, 1536, G, bx); S.Z.lo = 2; S.Z.sh = 14; S.Z.wgm = 4; S.Z.ubeg = -S.nR; S.Z.uend = ZFILL; pg8::EpiBf16<0> E{zs, ZW};
            REPS(5) { pg8::gemm_phase(lds, g, S, E); __syncthreads(); } SEAM(pb + 5); }
        if (IN(pb + 6)) { DCHK(4);
            const int NPOOL = (MR / 128) * 4, NGM = (MR / 128) * 4, NPG = NPOOL + NGM;
            REPS(6)
            if (G >= 256) {
                const int W2_TOTAL = (MR / 256) * (GW / 256), W2_SPLIT = W2_TOTAL - 0;
                if (bx < 128) { for (int r2 = 0; r2 < 1 + ((REPMASK >> 14) & 1); ++r2) { if (NAIVE_SCAN) phase_scan_naive(p, li, lds, bx); else phase_scan(p, li, lds, bx); }
                    WSP pg8::Gemm g = pg8::mkgemm_blk(hn, (const bf16_t*)(ws + W_IN) + (size_t)ZW * D, MR, GW, D); pg8::StaticOrder S; S.init(MR, GW, 128, bx); S.range(W2_SPLIT, W2_TOTAL); pg8::EpiGates E{gates, GW / 256};
                    pg8::gemm_phase(lds, g, S, E); }
                else { { WSP pg8::Gemm g = pg8::mkgemm_blk(hn, (const bf16_t*)(ws + W_IN), MR, ZW, D); pg8::ShiftOrder S; S.init(MR, 1536, G - 128, bx - 128); S.lo = 2; S.sh = 14; S.range(ZFILL, S.nwg); S.wgm = 4; pg8::EpiBf16<0> E{zs, ZW};
                        pg8::gemm_phase(lds, g, S, E); sub_barrier((unsigned*)(ws + WS_CTL), (unsigned*)(ws + WS_CTL) + 4096 + 64 * li, (unsigned)(G - 128)); }
                    for (int r2 = 0; r2 < 1 + ((REPMASK >> 15) & 1); ++r2) { int lastk = -1; for (int u = bx - 128; u < NPG; u += G - 128) { const int kind = (u < NPOOL ? 0 : 4) + (u & 3); if (u < NPOOL) pool_unit(p, li, u >> 2, u & 3, lds, kind != lastk); else gmlp_unit(p, li, (u - NPOOL) >> 2, u & 3, lds, kind != lastk); lastk = kind; } }
                    WSP pg8::Gemm g = pg8::mkgemm_blk(hn, (const bf16_t*)(ws + W_IN) + (size_t)ZW * D, MR, GW, D); pg8::StaticOrder S; S.init(MR, GW, G - 128, bx - 128); S.range(0, W2_SPLIT); S.wgm = 4; pg8::EpiGates E{gates, GW / 256};
                    pg8::gemm_phase(lds, g, S, E); }
            } else {
                for (int q = bx; q < 128; q += G) phase_scan(p, li, lds, q);
                { int lastk = -1; for (int u = bx; u < NPG; u += G) { const int kind = (u < NPOOL ? 0 : 4) + (u & 3); if (u < NPOOL) pool_unit(p, li, u >> 2, u & 3, lds, kind != lastk); else gmlp_unit(p, li, (u - NPOOL) >> 2, u & 3, lds, kind != lastk); lastk = kind; } }
                WSP pg8::Gemm g = pg8::mkgemm_blk(hn, (const bf16_t*)(ws + W_IN) + (size_t)ZW * D, MR, GW, D); pg8::StaticOrder S; S.init(MR, GW, G, bx); pg8::EpiGates E{gates, GW / 256};
                pg8::gemm_phase(lds, g, S, E);
            }
            SEAM(pb + 6); }
        if (IN(pb + 7)) { DCHK(8); DCHK(9); const int NTB = MR / 64; int last_sl = -1; REPS(7) for (int u = bx; u < NTB * 8; u += G) { post_unit(p, li, u % NTB, u / NTB, lds, last_sl != u / NTB); last_sl = u / NTB; } SEAM(pb + 7); }
        if (IN(pb + 9)) { DCHK(5); WSP
            REPS(9) { pg8::Gemm g = pg8::mkgemm(ycat, (const bf16_t*)(ws + W_PR), MR, D, D, D, D); g.lda = 64; g.kstepA = 32768; g.tstepA = (size_t)(D / 64) * 32768;     pg8::MergeOrder S; S.init(MR, D, G, bx); pg8::EpiMerge E{gates, hn};
                pg8::gemm_phase(lds, g, S, E); __syncthreads(); }
            if (early && li == 0 && bx >= 32) phase_conv(p, 1, lds, 0, CV_NEARLY, bx - 32, G - 32, (bf16_t*)((unsigned char*)p.out + EARLY_GU0), (bf16_t*)((unsigned char*)p.out + EARLY_D0), false);
            SEAM(pb + 9); }
        if (IN(pb + 10)) { DCHK(6); DCHK(70); WSP pg8::Gemm g = pg8::mkgemm_blk(hn, (const bf16_t*)(ws + W_OUT), MR, D, D); pg8::CtxSplitOrder S; S.init(MR, D, G, bx); S.wgm = 4; REPS(10) { pg8::EpiResB E{(bf16_t*)(ws + WS_XB), (float*)((unsigned char*)p.out + CTXP_OFF), modl + 5 * D, rep ? 0.0f : 1.0f}; pg8::gemm_phase(lds, g, S, E); __syncthreads(); } SEAM(pb + 10); }
        if (IN(pb + 11)) { DCHK(7); WSP REPS(11) phase_norm(p, li, 2, nullptr, hc, MR, false, MR > RLAT); SEAM(pb + 11); }
        if (IN(pb + 12)) { DCHK(13); WSP pg8::Gemm g = pg8::mkgemm_blk(hn, (const bf16_t*)(ws + W_GU1), MR, NGU, D); pg8::StaticOrder S; S.init(MR, NGU, G, bx); pg8::EpiGU E{hbuf};
            REPS(12) { pg8::gemm_phase(lds, g, S, E); __syncthreads(); } SEAM(pb + 12); }
        if (IN(pb + 13)) { DCHK(14); DCHK(110); WSP pg8::Gemm g = pg8::mkgemm_blk(hbuf, (const bf16_t*)(ws + W_D1), MR, D, FF); pg8::CtxSplitOrder S; S.init(MR, D, G, bx); S.wgm = 4; REPS(13) { pg8::EpiResB E{(bf16_t*)(ws + WS_XB), (float*)((unsigned char*)p.out + CTXP_OFF), modl + 8 * D, rep ? 0.0f : 0.5f}; pg8::gemm_phase(lds, g, S, E); __syncthreads(); } SEAM(pb + 13); }
    }
    if (IN(PH_FINAL)) { if (DBGCHK && DBGLAYER == 1) { dbg_check(p, 11); xcd_barrier(bar); } phase_final(p); }
#undef IN
#undef SEAM
}

extern "C" void kernel_launch(void* const* d_in, const int* in_sizes, int n_in, void* d_out, int out_size, void* d_ws, size_t ws_size, hipStream_t stream) {
    static int grid = 0;
    if (grid == 0) {
        if (n_in != 33 || in_sizes[0] != RLAT * D || out_size != RLAT * D || ws_size < WS_END) {
            fprintf(stderr, "kernel_launch: unexpected problem: n_in %d in0 %d out %d ws %zu (need %zu)\n", n_in, n_in > 0 ? in_sizes[0] : -1, out_size, ws_size, (size_t)WS_END); grid = -1; return; }
        int dev = 0, cus = 0, per_cu = 0;
        if (hipGetDevice(&dev) != hipSuccess || hipDeviceGetAttribute(&cus, hipDeviceAttributeMultiprocessorCount, dev) != hipSuccess) { grid = -1; return; }
        if (hipFuncSetAttribute((const void*)mk_fwd, hipFuncAttributeMaxDynamicSharedMemorySize, LDS_BYTES) != hipSuccess) { fprintf(stderr, "kernel_launch: hipFuncSetAttribute failed\n"); grid = -1; return; }
        if (hipOccupancyMaxActiveBlocksPerMultiprocessor(&per_cu, (const void*)mk_fwd, 512, LDS_BYTES) != hipSuccess || per_cu < 1) fprintf(stderr, "kernel_launch: occupancy query reports %d\n", per_cu);
        (void)hipGetLastError();
        grid = cus;
    }
    if (grid < 0) return;
    if (hipMemsetAsync((char*)d_ws + WS_CTL, 0, CTL_BYTES, stream) != hipSuccess) return;
    Params p{};
    for (int i = 0; i < 33; ++i) p.in[i] = (const float*)d_in[i];
    p.out = (float*)d_out; p.ws = (unsigned char*)d_ws;
#if MK_MULTI
    for (int ph = 0; ph < PH_TOTAL; ++ph) { p.ph_lo = ph; p.ph_hi = ph + 1; hipLaunchKernelGGL(mk_fwd, dim3(grid), dim3(512), LDS_BYTES, stream, p); }
#else
    p.ph_lo = 0; p.ph_hi = PH_TOTAL;
    hipLaunchKernelGGL(mk_fwd, dim3(grid), dim3(512), LDS_BYTES, stream, p);
#endif
}
```
